# Optimizing an MI355X kernel written in HIP

```python
import math
import jax, jax.numpy as jnp
from jax import lax
import numpy as np

D_MODEL = 1024
BATCH = 32
SEQ = 256
DEPTH = 4
DEC_BATCH = 4
DEC_SEQ = 4096
PAST_LEN = 512

GRID_W = 64
N_EVEN = (DEPTH + 1) // 2
N_ODD = DEPTH // 2
HEAD_DIM = 64
ATTN_SCALE = HEAD_DIM ** -0.5
ROPE_BASE = 10000.0
RMS_EPS = 1e-6
N_MOD = 6
A_HEADS = 8
A_KV_HEADS = 2
A_GROUP = A_HEADS // A_KV_HEADS
A_WINDOW = 128
A_BLOCK = 128
A_WIDTH = A_HEADS * HEAD_DIM
B_HEADS = 4
B_DK = 64
B_DV = 128
B_GATE_RANK = 16
B_GATE_TAU = 16.0
B_CHUNK = 64
B_WIDTH = B_HEADS * B_DV
C_HEADS = 8
C_DV = 2 * HEAD_DIM
C_BLOCK = 128
C_WIDTH = C_HEADS * C_DV
EVEN_SPLITS = (A_HEADS * HEAD_DIM, A_KV_HEADS * HEAD_DIM, A_KV_HEADS * HEAD_DIM, B_HEADS * B_DK, B_HEADS * B_DK, B_WIDTH, B_WIDTH, 2 * B_GATE_RANK)
EVEN_IN = sum(EVEN_SPLITS)
EVEN_OUT = A_WIDTH + B_WIDTH
ODD_IN = 3 * C_WIDTH
P_HEADS = 8
P_NKEYS = 128
P_EXPERTS = P_NKEYS * P_NKEYS
P_DKEY = 128
P_TOPK = 16
P_BLOCK = 128

kernel_name = 'hybrid_diffusion_prefix_trunk_step'

F32 = jnp.float32


def rmsnorm(x, g):
    xf = x.astype(F32)
    y = xf * lax.rsqrt(jnp.mean(xf * xf, axis=-1, keepdims=True) + RMS_EPS)
    return (y * g.astype(F32)).astype(x.dtype)


def modulation(cvec, w, b):
    m = (jax.nn.silu(cvec) @ w + b)[:, None, :]
    return jnp.split(m, N_MOD, axis=-1)


def rope_2d(T):
    rows = T // GRID_W
    t = jnp.arange(rows * GRID_W)
    row = (t // GRID_W).astype(F32)
    col = (t % GRID_W).astype(F32)
    nf = HEAD_DIM // 4
    freqs = ROPE_BASE ** (-jnp.arange(nf, dtype=F32) / nf)
    ang = jnp.stack([row[:, None] * freqs, col[:, None] * freqs], axis=1)
    return jnp.cos(ang), jnp.sin(ang)


def apply_rope_2d(x, cos, sin):
    extra = x.ndim - 3
    shp = (cos.shape[0],) + (1,) * extra + cos.shape[1:]
    cs = cos.reshape(shp)
    sn = sin.reshape(shp)
    xr = x.astype(F32).reshape(x.shape[:-1] + (2, 2, HEAD_DIM // 4))
    x1 = xr[..., 0, :]
    x2 = xr[..., 1, :]
    out = jnp.stack([x1 * cs - x2 * sn, x2 * cs + x1 * sn], axis=-2)
    return out.reshape(x.shape).astype(x.dtype)


def attn_sink_dense(q, k, v, sink):
    B, Tq = q.shape[:2]
    s = jnp.einsum('bqkgd,bckd->bkgqc', q, k).astype(F32) * ATTN_SCALE
    sk = jnp.broadcast_to(sink.astype(F32)[None, :, :, None, None], s.shape[:-1] + (1,))
    p = jax.nn.softmax(jnp.concatenate([s, sk], axis=-1), axis=-1)[..., :-1]
    out = jnp.einsum('bkgqc,bckd->bqkgd', p.astype(v.dtype), v)
    return out.reshape(B, Tq, A_WIDTH)


def attn_window_ctx(q, k, v, kc, vc, sink):
    B, T = q.shape[:2]
    W = A_BLOCK
    NB = T // W
    Lc = kc.shape[1]
    qb = q.reshape(B, NB, W, A_KV_HEADS, A_GROUP, HEAD_DIM)

    def band(x):
        xp = jnp.pad(x, ((0, 0), (W, W), (0, 0), (0, 0))).reshape(B, NB + 2, W, A_KV_HEADS, HEAD_DIM)
        return jnp.concatenate([xp[:, :-2], xp[:, 1:-1], xp[:, 2:]], axis=2)

    kw = band(k)
    vw = band(v)
    s_w = jnp.einsum('bnikgd,bnjkd->bnkgij', qb, kw).astype(F32) * ATTN_SCALE
    blk = jnp.arange(NB)[:, None, None] * W
    qpos = blk + jnp.arange(W)[None, :, None]
    kpos = blk - W + jnp.arange(3 * W)[None, None, :]
    valid = (jnp.abs(qpos - kpos) <= A_WINDOW) & (kpos >= 0) & (kpos < T)
    s_w = jnp.where(valid[None, :, None, None], s_w, -jnp.inf)
    s_c = jnp.einsum('bnikgd,bckd->bnkgic', qb, kc).astype(F32) * ATTN_SCALE
    sk = jnp.broadcast_to(sink.astype(F32)[None, None, :, :, None, None], s_c.shape[:-1] + (1,))
    p = jax.nn.softmax(jnp.concatenate([s_w, s_c, sk], axis=-1), axis=-1)
    pw = p[..., :3 * W].astype(v.dtype)
    pc = p[..., 3 * W:3 * W + Lc].astype(v.dtype)
    out = jnp.einsum('bnkgij,bnjkd->bnikgd', pw, vw) + jnp.einsum('bnkgic,bckd->bnikgd', pc, vc)
    return out.reshape(B, T, A_WIDTH)


def gla_chunked(q, k, v, lg, s0):
    B, H, T, dk = q.shape
    dv = v.shape[-1]
    L = B_CHUNK
    N = T // L
    q = q.reshape(B, H, N, L, dk)
    k = k.reshape(B, H, N, L, dk)
    v = v.reshape(B, H, N, L, dv)
    b = jnp.cumsum(lg.reshape(B, H, N, L, dk), axis=3)
    b_last = b[:, :, :, -1:, :]
    qd = q * jnp.exp(b)
    kd = k * jnp.exp(-b)
    kt = k * jnp.exp(b_last - b)
    causal = jnp.tril(jnp.ones((L, L), dtype=bool))
    a = jnp.where(causal, jnp.einsum('bhnid,bhnjd->bhnij', qd, kd), 0.0)
    o_intra = jnp.einsum('bhnij,bhnjv->bhniv', a, v)
    kv = jnp.einsum('bhnjd,bhnjv->nbhdv', kt, v)
    decay = jnp.moveaxis(jnp.exp(b_last[:, :, :, 0, :]), 2, 0)

    def step(s, inp):
        dec, kvn = inp
        return dec[..., None] * s + kvn, s

    s_fin, s_starts = lax.scan(step, s0, (decay, kv))
    o_inter = jnp.einsum('bhnid,nbhdv->bhniv', qd, s_starts)
    return (o_intra + o_inter).reshape(B, H, T, dv), s_fin


def gla_bidir(q, k, v, lg_f, lg_b, s0_f, s0_b):
    def tr(x):
        return jnp.swapaxes(x, 1, 2).astype(F32)

    def fl(x):
        return jnp.flip(x, axis=2)

    qh = tr(q) * (B_DK ** -0.5)
    kh = tr(k)
    vh = tr(v)
    of, sf = gla_chunked(qh, kh, vh, tr(lg_f), s0_f.astype(F32))
    ob, sb = gla_chunked(fl(qh), fl(kh), fl(vh), fl(tr(lg_b)), s0_b.astype(F32))
    o = of + fl(ob)
    return jnp.swapaxes(o, 1, 2), sf, sb


def even_project(h, w_in, a_qn, a_kn, gw_f, gb_f, gw_b, gb_b):
    B, T, _ = h.shape
    offs = [int(o) for o in np.cumsum(EVEN_SPLITS)[:-1]]
    aq, ak, av, bq, bk, bv, br, bg = jnp.split(h @ w_in, offs, axis=-1)
    aq = rmsnorm(aq.reshape(B, T, A_KV_HEADS, A_GROUP, HEAD_DIM), a_qn)
    ak = rmsnorm(ak.reshape(B, T, A_KV_HEADS, HEAD_DIM), a_kn)
    av = av.reshape(B, T, A_KV_HEADS, HEAD_DIM)
    bq = bq.reshape(B, T, B_HEADS, B_DK)
    bk = bk.reshape(B, T, B_HEADS, B_DK)
    bv = bv.reshape(B, T, B_HEADS, B_DV)
    bgf, bgb = jnp.split(bg, 2, axis=-1)
    lg_f = (jax.nn.log_sigmoid((bgf @ gw_f + gb_f).astype(F32)) / B_GATE_TAU).reshape(B, T, B_HEADS, B_DK)
    lg_b = (jax.nn.log_sigmoid((bgb @ gw_b + gb_b).astype(F32)) / B_GATE_TAU).reshape(B, T, B_HEADS, B_DK)
    return aq, ak, av, bq, bk, bv, br, lg_f, lg_b


def even_output(oa, ob, br, b_on, w_out):
    B, T, _ = oa.shape
    ob = rmsnorm(ob.astype(br.dtype), b_on).reshape(B, T, B_WIDTH) * jax.nn.silu(br)
    return jnp.concatenate([oa, ob.astype(oa.dtype)], axis=-1) @ w_out


def odd_project(h, w_in, q_norm, k_norm):
    B, T, _ = h.shape
    q, k, v = jnp.split(h @ w_in, 3, axis=-1)
    q = rmsnorm(q.reshape(B, T, C_HEADS, 2, HEAD_DIM), q_norm)
    k = rmsnorm(k.reshape(B, T, C_HEADS, 2, HEAD_DIM), k_norm)
    return q, k, v.reshape(B, T, C_HEADS, C_DV)


def diff_lambda(lq1, lk1, lq2, lk2, lam_init):
    return (jnp.exp(jnp.sum(lq1.astype(F32) * lk1.astype(F32))) - jnp.exp(jnp.sum(lq2.astype(F32) * lk2.astype(F32))) + lam_init)


def diff_attention(q, k, v, lam):
    B, Tq = q.shape[:2]
    NB = Tq // C_BLOCK
    qb = jnp.moveaxis(q.reshape(B, NB, C_BLOCK, C_HEADS, 2, HEAD_DIM), 1, 0)

    def block(qi):
        s = jnp.einsum('bihmd,bjhmd->bhmij', qi, k).astype(F32) * ATTN_SCALE
        p = jax.nn.softmax(s, axis=-1)
        pd = p[:, :, 0] - lam * p[:, :, 1]
        return jnp.einsum('bhij,bjhv->bihv', pd.astype(v.dtype), v)

    o = lax.map(block, qb)
    return jnp.moveaxis(o, 0, 1).reshape(B, Tq, C_HEADS, C_DV)


def odd_output(o, c_on, lam_init, w_out):
    B, T = o.shape[:2]
    o = rmsnorm(o, c_on) * (1.0 - lam_init)
    return o.reshape(B, T, C_WIDTH) @ w_out


def lambda_init(layer):
    return 0.8 - 0.6 * math.exp(-0.3 * layer)


def peer(h, wq, sub_keys, u, v):
    B, T, D = h.shape
    xs = h.reshape(-1, P_BLOCK, D)

    def block(xc):
        q = (xc @ wq).reshape(P_BLOCK, P_HEADS, 2, P_DKEY // 2)
        s = jnp.einsum('chpd,hpkd->chpk', q, sub_keys).astype(F32)
        sv, si = lax.top_k(s, P_TOPK)
        cand = (sv[:, :, 0, :, None] + sv[:, :, 1, None, :]).reshape(P_BLOCK, P_HEADS, P_TOPK * P_TOPK)
        cidx = (si[:, :, 0, :, None] * P_NKEYS + si[:, :, 1, None, :]).reshape(P_BLOCK, P_HEADS, P_TOPK * P_TOPK)
        fs, fi = lax.top_k(cand, P_TOPK)
        eidx = jnp.take_along_axis(cidx, fi, axis=-1)
        g = jax.nn.softmax(fs, axis=-1)
        act = jax.nn.gelu(jnp.einsum('cd,chkd->chk', xc, u[eidx]).astype(F32), approximate=False)
        return jnp.einsum('chk,chkd->cd', (g * act).astype(v.dtype), v[eidx])

    return lax.map(block, xs).reshape(B, T, D)


def setup_inputs(seed: int = 0) -> dict:
    key = jax.random.key(seed)
    ks = iter(jax.random.split(key, 64))
    D = D_MODEL

    def nrm(shape, scale):
        return jax.random.normal(next(ks), shape, jnp.float32) * scale

    def gain(shape):
        return 1.0 + nrm(shape, 0.1)

    return {
        'x_prompt': nrm((BATCH, SEQ, D), 1.0),
        'x_sample': nrm((DEC_BATCH, DEC_SEQ, D), 1.0),
        'cache_a_k': nrm((DEC_BATCH, N_EVEN, PAST_LEN, A_KV_HEADS, HEAD_DIM), 1.0),
        'cache_a_v': nrm((DEC_BATCH, N_EVEN, PAST_LEN, A_KV_HEADS, HEAD_DIM), 1.0),
        'state_b_fwd': nrm((DEC_BATCH, N_EVEN, B_HEADS, B_DK, B_DV), 0.5),
        'state_b_bwd': nrm((DEC_BATCH, N_EVEN, B_HEADS, B_DK, B_DV), 0.5),
        'cache_c_k': nrm((DEC_BATCH, N_ODD, PAST_LEN, C_HEADS, 2, HEAD_DIM), 1.0),
        'cache_c_v': nrm((DEC_BATCH, N_ODD, PAST_LEN, C_HEADS, C_DV), 1.0),
        'c': nrm((DEC_BATCH, D), 1.0),
        'c_ctx': nrm((D,), 1.0),
        'ada_w': nrm((DEPTH, D, N_MOD * D), 0.5 * D ** -0.5),
        'ada_b': nrm((DEPTH, N_MOD * D), 0.02),
        'norm_mix_g': gain((DEPTH, D)),
        'norm_ffn_g': gain((DEPTH, D)),
        'e_w_in': nrm((N_EVEN, D, EVEN_IN), D ** -0.5),
        'e_w_out': nrm((N_EVEN, EVEN_OUT, D), EVEN_OUT ** -0.5),
        'a_q_norm': gain((N_EVEN, HEAD_DIM)),
        'a_k_norm': gain((N_EVEN, HEAD_DIM)),
        'a_sink': nrm((N_EVEN, A_KV_HEADS, A_GROUP), 0.5),
        'b_gate_w_f': nrm((N_EVEN, B_GATE_RANK, B_HEADS * B_DK), B_GATE_RANK ** -0.5),
        'b_gate_b_f': nrm((N_EVEN, B_HEADS * B_DK), 0.1),
        'b_gate_w_b': nrm((N_EVEN, B_GATE_RANK, B_HEADS * B_DK), B_GATE_RANK ** -0.5),
        'b_gate_b_b': nrm((N_EVEN, B_HEADS * B_DK), 0.1),
        'b_out_norm': gain((N_EVEN, B_DV)),
        'o_w_in': nrm((N_ODD, D, ODD_IN), D ** -0.5),
        'o_w_out': nrm((N_ODD, C_WIDTH, D), C_WIDTH ** -0.5),
        'c_q_norm': gain((N_ODD, HEAD_DIM)),
        'c_k_norm': gain((N_ODD, HEAD_DIM)),
        'c_lambda_q1': nrm((N_ODD, HEAD_DIM), 0.1),
        'c_lambda_k1': nrm((N_ODD, HEAD_DIM), 0.1),
        'c_lambda_q2': nrm((N_ODD, HEAD_DIM), 0.1),
        'c_lambda_k2': nrm((N_ODD, HEAD_DIM), 0.1),
        'c_out_norm': gain((N_ODD, C_DV)),
        'p_w_q': nrm((DEPTH, D, P_HEADS * P_DKEY), D ** -0.5),
        'p_sub_keys': nrm((DEPTH, P_HEADS, 2, P_NKEYS, P_DKEY // 2), (P_DKEY // 2) ** -0.5),
        'p_u': nrm((DEPTH, P_EXPERTS, D), D ** -0.5),
        'p_v': nrm((DEPTH, P_EXPERTS, D), 0.25),
    }


def reference(x_prompt, x_sample, cache_a_k, cache_a_v, state_b_fwd, state_b_bwd, cache_c_k, cache_c_v, c, c_ctx, ada_w, ada_b, norm_mix_g, norm_ffn_g, e_w_in, e_w_out, a_q_norm, a_k_norm, a_sink, b_gate_w_f, b_gate_b_f, b_gate_w_b, b_gate_b_b, b_out_norm, o_w_in, o_w_out, c_q_norm, c_k_norm, c_lambda_q1, c_lambda_k1, c_lambda_q2, c_lambda_k2, c_out_norm, p_w_q, p_sub_keys, p_u, p_v):
    cos, sin = rope_2d(x_sample.shape[1])

    xp = x_prompt
    Bp = xp.shape[0]
    ak_l, av_l, sf_l, sb_l, ck_l, cv_l = [], [], [], [], [], []
    for l in range(DEPTH):
        i = l // 2
        sh1, sc1, g1, sh2, sc2, g2 = modulation(c_ctx[None, :], ada_w[l], ada_b[l])
        h = rmsnorm(xp, norm_mix_g[l]) * (1.0 + sc1) + sh1
        if l % 2 == 0:
            aq, ak, av, bq, bk, bv, br, lgf, lgb = even_project(h, e_w_in[i], a_q_norm[i], a_k_norm[i], b_gate_w_f[i], b_gate_b_f[i], b_gate_w_b[i], b_gate_b_b[i])
            oa = attn_sink_dense(aq, ak, av, a_sink[i])
            s0 = jnp.zeros((Bp, B_HEADS, B_DK, B_DV), F32)
            ob, sf, sb = gla_bidir(bq, bk, bv, lgf, lgb, s0, s0)
            o = even_output(oa, ob, br, b_out_norm[i], e_w_out[i])
            ak_l.append(ak)
            av_l.append(av)
            sf_l.append(sf)
            sb_l.append(sb)
        else:
            lam_init = lambda_init(l)
            lam = diff_lambda(c_lambda_q1[i], c_lambda_k1[i], c_lambda_q2[i], c_lambda_k2[i], lam_init)
            q, k, v = odd_project(h, o_w_in[i], c_q_norm[i], c_k_norm[i])
            o = odd_output(diff_attention(q, k, v, lam), c_out_norm[i], lam_init, o_w_out[i])
            ck_l.append(k)
            cv_l.append(v)
        xp = xp + g1 * o
        h = rmsnorm(xp, norm_ffn_g[l]) * (1.0 + sc2) + sh2
        xp = xp + g2 * peer(h, p_w_q[l], p_sub_keys[l], p_u[l], p_v[l])

    xs = x_sample
    for l in range(DEPTH):
        i = l // 2
        sh1, sc1, g1, sh2, sc2, g2 = modulation(c, ada_w[l], ada_b[l])
        h = rmsnorm(xs, norm_mix_g[l]) * (1.0 + sc1) + sh1
        if l % 2 == 0:
            aq, ak, av, bq, bk, bv, br, lgf, lgb = even_project(h, e_w_in[i], a_q_norm[i], a_k_norm[i], b_gate_w_f[i], b_gate_b_f[i], b_gate_w_b[i], b_gate_b_b[i])
            aq = apply_rope_2d(aq, cos, sin)
            ak = apply_rope_2d(ak, cos, sin)
            oa = attn_window_ctx(aq, ak, av, cache_a_k[:, i].astype(ak.dtype), cache_a_v[:, i].astype(av.dtype), a_sink[i])
            ob, _, _ = gla_bidir(bq, bk, bv, lgf, lgb, state_b_fwd[:, i], state_b_bwd[:, i])
            o = even_output(oa, ob, br, b_out_norm[i], e_w_out[i])
        else:
            lam_init = lambda_init(l)
            lam = diff_lambda(c_lambda_q1[i], c_lambda_k1[i], c_lambda_q2[i], c_lambda_k2[i], lam_init)
            q, k, v = odd_project(h, o_w_in[i], c_q_norm[i], c_k_norm[i])
            q = apply_rope_2d(q, cos, sin)
            k = apply_rope_2d(k, cos, sin)
            k_all = jnp.concatenate([k, cache_c_k[:, i].astype(k.dtype)], axis=1)
            v_all = jnp.concatenate([v, cache_c_v[:, i].astype(v.dtype)], axis=1)
            o = odd_output(diff_attention(q, k_all, v_all, lam), c_out_norm[i], lam_init, o_w_out[i])
        xs = xs + g1 * o
        h = rmsnorm(xs, norm_ffn_g[l]) * (1.0 + sc2) + sh2
        xs = xs + g2 * peer(h, p_w_q[l], p_sub_keys[l], p_u[l], p_v[l])

    new_cache_a_k = jnp.stack(ak_l, axis=1)
    new_cache_a_v = jnp.stack(av_l, axis=1)
    new_state_b_fwd = jnp.stack(sf_l, axis=1)
    new_state_b_bwd = jnp.stack(sb_l, axis=1)
    new_cache_c_k = jnp.stack(ck_l, axis=1)
    new_cache_c_v = jnp.stack(cv_l, axis=1)
    return (xp, xs, new_cache_a_k, new_cache_a_v, new_state_b_fwd, new_state_b_bwd, new_cache_c_k, new_cache_c_v)
```

```cpp
#include <hip/hip_runtime.h>
#include <hip/hip_cooperative_groups.h>
#include <cmath>
#include <cstdio>
namespace cg = cooperative_groups;

typedef unsigned short u16;
typedef short bf16x8 __attribute__((ext_vector_type(8)));
typedef float f32x16 __attribute__((ext_vector_type(16)));
typedef __bf16 bf16x2_t __attribute__((ext_vector_type(2)));
typedef float f32x2_t __attribute__((ext_vector_type(2)));
typedef unsigned u32x4 __attribute__((ext_vector_type(4)));
typedef unsigned u32x2 __attribute__((ext_vector_type(2)));
typedef float f32x4 __attribute__((ext_vector_type(4)));
#define DI __device__ __forceinline__
#define MFMA(a, b, c) __builtin_amdgcn_mfma_f32_32x32x16_bf16((a), (b), (c), 0, 0, 0)

constexpr int D = 1024;
constexpr int NTOK = 24576;
constexpr int NCTX = 8192;
constexpr int EIN_PAD = 2432;
constexpr float LOG2E = 1.4426950408889634f;
constexpr float QSCALE = 0.125f * LOG2E;
constexpr float EPS = 1e-6f;

enum { I_XP = 0, I_XS, I_CAK, I_CAV, I_SBF, I_SBB, I_CCK, I_CCV, I_C, I_CCTX, I_ADAW, I_ADAB, I_NMG, I_NFG, I_EWIN, I_EWOUT,
       I_AQN, I_AKN, I_ASINK, I_GWF, I_GBF, I_GWB, I_GBB, I_BON, I_OWIN, I_OWOUT, I_CQN, I_CKN, I_LQ1, I_LK1, I_LQ2, I_LK2, I_CON,
       I_PWQ, I_PSK, I_PU, I_PV, N_IN };

constexpr size_t O_X = 0;
constexpr size_t O_CAK = 25165824;
constexpr size_t O_CAV = 27262976;
constexpr size_t O_SBF = 29360128;
constexpr size_t O_SBB = 31457280;
constexpr size_t O_CCK = 33554432;
constexpr size_t O_CCV = 50331648;

constexpr size_t W_EIN = 0;
constexpr size_t W_OIN = W_EIN + 2ull * EIN_PAD * 1024 * 2;
constexpr size_t W_EOUT = W_OIN + 2ull * 3072 * 1024 * 2;
constexpr size_t W_OOUT = W_EOUT + 2ull * 1024 * 1024 * 2;
constexpr size_t W_PQ = W_OOUT + 2ull * 1024 * 1024 * 2;
constexpr size_t W_SK = W_PQ + 4ull * 1024 * 1024 * 2;
constexpr size_t W_PU = W_SK + 4ull * 8 * 2 * 128 * 64 * 2;
constexpr size_t W_PV = W_PU + 4ull * 16384 * 1024 * 2;
constexpr size_t W_MOD = W_PV + 4ull * 16384 * 1024 * 2;
constexpr size_t W_ROPE = W_MOD + 4ull * 5 * 6144 * 4;
constexpr size_t W_LAM = W_ROPE + 64 * 16 * 2 * 4;
constexpr size_t W_H = W_LAM + 256;
constexpr size_t W_Q = W_H + (size_t)NTOK * 1024 * 2;
constexpr size_t W_OMIX = W_Q + (size_t)NTOK * 1024 * 2;
constexpr size_t SZ_KA_DEC = 4ull * 2 * 4608 * 64 * 2;
constexpr size_t W_KA_DEC = W_OMIX + (size_t)NTOK * 1024 * 2;
constexpr size_t W_VAT_DEC = W_KA_DEC + 2 * SZ_KA_DEC;
constexpr size_t W_KA_CTX = W_VAT_DEC + 2 * SZ_KA_DEC;
constexpr size_t W_VAT_CTX = W_KA_CTX + 32ull * 2 * 256 * 64 * 2;
constexpr size_t SZ_KC_DEC = 4ull * 8 * 2 * 4608 * 64 * 2;
constexpr size_t W_KC_DEC = W_VAT_CTX + 32ull * 2 * 256 * 64 * 2;
constexpr size_t W_VCT_DEC = W_KC_DEC + 2 * SZ_KC_DEC;
constexpr size_t W_KC_CTX = W_VCT_DEC + 2 * SZ_KC_DEC;
constexpr size_t W_VCT_CTX = W_KC_CTX + 32ull * 8 * 2 * 256 * 64 * 2;
constexpr size_t W_BQ = W_VCT_CTX + 32ull * 8 * 128 * 256 * 2;
constexpr size_t W_BK = W_BQ + (size_t)NTOK * 256 * 2;
constexpr size_t W_BV = W_BK + (size_t)NTOK * 256 * 2;
constexpr size_t W_BR = W_BV + (size_t)NTOK * 512 * 2;
constexpr size_t W_BG = W_BR + (size_t)NTOK * 512 * 2;
constexpr size_t W_KV = W_BG + (size_t)NTOK * 32 * 4;
constexpr size_t W_DEC = W_KV + 1536ull * 2 * 8192 * 4;
constexpr size_t W_EIDX = W_DEC + 1536ull * 2 * 64 * 4;
constexpr size_t W_EGATE = W_EIDX + (size_t)NTOK * 128 * 4;
constexpr size_t W_PSU = W_EGATE + (size_t)NTOK * 128 * 4;
constexpr size_t W_PSV = W_PSU + 4ull * 16384 * 4;
constexpr size_t W_END = W_PSV + 4ull * 16384 * 4;
constexpr size_t W_BAR = W_END;
static_assert(W_BAR + 16384 < (1ull << 30), "workspace budget");

struct Params {
  const float* in[N_IN];
  float* out;
  char* ws;
  float lam_init[2];
  int rep[8];
};

constexpr int SMEM_BYTES = 256 * 129 * 4 + 512;

DI unsigned pk2(float a, float b) {
  f32x2_t v = {a, b};
  bf16x2_t r = __builtin_convertvector(v, bf16x2_t);
  return __builtin_bit_cast(unsigned, r);
}
DI u16 f2bf(float a) { return (u16)(pk2(a, 0.f) & 0xffffu); }
DI float bf2f(u16 v) { return __uint_as_float(((unsigned)v) << 16); }
DI float bflo(unsigned w) { return __uint_as_float(w << 16); }
DI float bfhi(unsigned w) { return __uint_as_float(w & 0xffff0000u); }
DI int crow(int g, int h) { return (g & 3) + 8 * (g >> 2) + 4 * h; }
DI int pi32(int r) { return (r & ~12) | ((r & 4) << 1) | ((r & 8) >> 1); }
DI bf16x8 ld8(const u16* p) { return __builtin_bit_cast(bf16x8, *(const u32x4*)p); }
DI float wave_sum(float v) {
#pragma unroll
  for (int o = 32; o >= 1; o >>= 1) v += __shfl_xor(v, o);
  return v;
}
DI float silu_f(float x) { return x / (1.f + __expf(-x)); }
DI float dot2bf(unsigned a, unsigned b, float acc) {
  return __builtin_amdgcn_fdot2_f32_bf16(__builtin_bit_cast(bf16x2_t, a), __builtin_bit_cast(bf16x2_t, b), acc, false);
}
DI void tokinfo(int t, int& isdec, int& b, int& s, int& mi) {
  if (t < NCTX) { isdec = 0; b = t >> 8; s = t & 255; mi = 0; }
  else { int u = t - NCTX; isdec = 1; b = u >> 12; s = u & 4095; mi = 1 + b; }
}

DI void transpose_w(const float* __restrict__ src, u16* __restrict__ dst, int N, int Npad) {
  size_t total = (size_t)Npad * 32;
  for (size_t idx = (size_t)blockIdx.x * blockDim.x + threadIdx.x; idx < total; idx += (size_t)gridDim.x * blockDim.x) {
    int n = (int)(idx % Npad), kq = (int)(idx / Npad);
    float v[32];
#pragma unroll
    for (int j = 0; j < 32; ++j) v[j] = (n < N) ? src[(size_t)(kq * 32 + j) * N + n] : 0.f;
#pragma unroll
    for (int q = 0; q < 4; ++q) {
      u32x4 o = {pk2(v[q * 8], v[q * 8 + 1]), pk2(v[q * 8 + 2], v[q * 8 + 3]), pk2(v[q * 8 + 4], v[q * 8 + 5]), pk2(v[q * 8 + 6], v[q * 8 + 7])};
      *(u32x4*)(dst + (size_t)n * 1024 + kq * 32 + q * 8) = o;
    }
  }
}
DI void convert_bf16(const float* __restrict__ src, u16* __restrict__ dst, size_t n) {
  size_t n8 = n >> 3;
  for (size_t idx = (size_t)blockIdx.x * blockDim.x + threadIdx.x; idx < n8; idx += (size_t)gridDim.x * blockDim.x) {
    f32x4 a = ((const f32x4*)src)[idx * 2], b = ((const f32x4*)src)[idx * 2 + 1];
    u32x4 o = {pk2(a.x, a.y), pk2(a.z, a.w), pk2(b.x, b.y), pk2(b.z, b.w)};
    ((u32x4*)dst)[idx] = o;
  }
}

DI void prep_phase(const Params& P, char* smem) {
  char* ws = P.ws;
  const int tid = threadIdx.x;
  const size_t gtid = (size_t)blockIdx.x * blockDim.x + tid, gsz = (size_t)gridDim.x * blockDim.x;
  {
    float* sS = (float*)smem;
    float* sR = sS + 5 * 1024;
    for (int idx = tid; idx < 5 * 1024; idx += 256) {
      int ci = idx >> 10, k = idx & 1023;
      float c = (ci == 0) ? P.in[I_CCTX][k] : P.in[I_C][(ci - 1) * 1024 + k];
      sS[idx] = silu_f(c);
    }
    __syncthreads();
    float* mod = (float*)(ws + W_MOD);
    for (int item = blockIdx.x; item < 4 * 96; item += gridDim.x) {
      int l = item / 96, ch = item % 96;
      int col = tid & 63, kq = tid >> 6;
      const float* w = P.in[I_ADAW] + (size_t)l * 1024 * 6144 + ch * 64 + col;
      float a0 = 0, a1 = 0, a2 = 0, a3 = 0, a4 = 0;
#pragma unroll 16
      for (int k = kq * 256; k < kq * 256 + 256; ++k) {
        float wv = w[(size_t)k * 6144];
        a0 += sS[k] * wv; a1 += sS[1024 + k] * wv; a2 += sS[2048 + k] * wv; a3 += sS[3072 + k] * wv; a4 += sS[4096 + k] * wv;
      }
      sR[(kq * 5 + 0) * 64 + col] = a0; sR[(kq * 5 + 1) * 64 + col] = a1; sR[(kq * 5 + 2) * 64 + col] = a2;
      sR[(kq * 5 + 3) * 64 + col] = a3; sR[(kq * 5 + 4) * 64 + col] = a4;
      __syncthreads();
      for (int idx = tid; idx < 320; idx += 256) {
        int ci = idx >> 6, c2 = idx & 63;
        float s = sR[(0 * 5 + ci) * 64 + c2] + sR[(1 * 5 + ci) * 64 + c2] + sR[(2 * 5 + ci) * 64 + c2] + sR[(3 * 5 + ci) * 64 + c2];
        mod[((size_t)l * 5 + ci) * 6144 + ch * 64 + c2] = s + P.in[I_ADAB][l * 6144 + ch * 64 + c2];
      }
      __syncthreads();
    }
  }
  for (int i = 0; i < 2; ++i) {
    transpose_w(P.in[I_EWIN] + (size_t)i * 1024 * 2336, (u16*)(ws + W_EIN) + (size_t)i * EIN_PAD * 1024, 2336, EIN_PAD);
    transpose_w(P.in[I_OWIN] + (size_t)i * 1024 * 3072, (u16*)(ws + W_OIN) + (size_t)i * 3072 * 1024, 3072, 3072);
    transpose_w(P.in[I_EWOUT] + (size_t)i * 1024 * 1024, (u16*)(ws + W_EOUT) + (size_t)i * 1024 * 1024, 1024, 1024);
    transpose_w(P.in[I_OWOUT] + (size_t)i * 1024 * 1024, (u16*)(ws + W_OOUT) + (size_t)i * 1024 * 1024, 1024, 1024);
  }
  for (int l = 0; l < 4; ++l)
    transpose_w(P.in[I_PWQ] + (size_t)l * 1024 * 1024, (u16*)(ws + W_PQ) + (size_t)l * 1024 * 1024, 1024, 1024);
  convert_bf16(P.in[I_PSK], (u16*)(ws + W_SK), 4ull * 8 * 2 * 128 * 64);
  {
    const int lane = tid & 63, wv = tid >> 6;
    for (int row0 = (blockIdx.x * 4 + wv) * 4; row0 < 2 * 65536; row0 += gridDim.x * 16) {
      const int which = row0 >> 16, rr0 = row0 & 65535;
      const float* srcp = P.in[which ? I_PV : I_PU] + (size_t)rr0 * 1024 + lane * 16;
      f32x4 a[4][4];
#pragma unroll
      for (int q = 0; q < 4; ++q)
#pragma unroll
        for (int j = 0; j < 4; ++j) a[q][j] = *(const f32x4*)(srcp + (size_t)q * 1024 + j * 4);
#pragma unroll
      for (int q = 0; q < 4; ++q) {
        float m = 0.f;
#pragma unroll
        for (int j = 0; j < 4; ++j) m = fmaxf(m, fmaxf(fmaxf(fabsf(a[q][j].x), fabsf(a[q][j].y)), fmaxf(fabsf(a[q][j].z), fabsf(a[q][j].w))));
#pragma unroll
        for (int o = 32; o >= 1; o >>= 1) m = fmaxf(m, __shfl_xor(m, o));
        const float sc = (m > 0.f) ? m * (1.f / 440.f) : 1.f;
        const float inv = 1.f / sc;
        if (which) {
          const float sc4 = (m > 0.f) ? m * (1.f / 6.f) : 1.f;
          const float inv4 = 1.f / sc4;
          unsigned w0 = 0, w1 = 0;
          w0 = __builtin_amdgcn_cvt_scalef32_pk_fp4_f32(w0, a[q][0].x * inv4, a[q][0].y * inv4, 1.0f, 0);
          w0 = __builtin_amdgcn_cvt_scalef32_pk_fp4_f32(w0, a[q][0].z * inv4, a[q][0].w * inv4, 1.0f, 1);
          w0 = __builtin_amdgcn_cvt_scalef32_pk_fp4_f32(w0, a[q][1].x * inv4, a[q][1].y * inv4, 1.0f, 2);
          w0 = __builtin_amdgcn_cvt_scalef32_pk_fp4_f32(w0, a[q][1].z * inv4, a[q][1].w * inv4, 1.0f, 3);
          w1 = __builtin_amdgcn_cvt_scalef32_pk_fp4_f32(w1, a[q][2].x * inv4, a[q][2].y * inv4, 1.0f, 0);
          w1 = __builtin_amdgcn_cvt_scalef32_pk_fp4_f32(w1, a[q][2].z * inv4, a[q][2].w * inv4, 1.0f, 1);
          w1 = __builtin_amdgcn_cvt_scalef32_pk_fp4_f32(w1, a[q][3].x * inv4, a[q][3].y * inv4, 1.0f, 2);
          w1 = __builtin_amdgcn_cvt_scalef32_pk_fp4_f32(w1, a[q][3].z * inv4, a[q][3].w * inv4, 1.0f, 3);
          u32x2 o = {w0, w1};
          *(u32x2*)(ws + W_PU + (size_t)(rr0 + q) * 1536 + 1024 + lane * 8) = o;
          if (lane == 0) ((float*)(ws + W_PSV))[rr0 + q] = sc4;
        } else {
          unsigned w[4];
#pragma unroll
          for (int j = 0; j < 4; ++j) {
            int t = __builtin_amdgcn_cvt_pk_fp8_f32(a[q][j].x * inv, a[q][j].y * inv, 0, false);
            t = __builtin_amdgcn_cvt_pk_fp8_f32(a[q][j].z * inv, a[q][j].w * inv, t, true);
            w[j] = (unsigned)t;
          }
          u32x4 o = {w[0], w[1], w[2], w[3]};
          *(u32x4*)(ws + W_PU + (size_t)(rr0 + q) * 1536 + lane * 16) = o;
          if (lane == 0) ((float*)(ws + W_PSU))[rr0 + q] = sc;
        }
      }
    }
  }
  {
    size_t n = 4ull * 2 * 512 * 2 * 64;
    for (size_t idx = gtid; idx < n; idx += gsz) {
      int d = idx & 63, kv = (idx >> 6) & 1, s = (idx >> 7) & 511, i = (idx >> 16) & 1, b = (int)(idx >> 17);
      float kvv = P.in[I_CAK][idx], vv = P.in[I_CAV][idx];
      u16* ka = (u16*)(ws + W_KA_DEC + i * SZ_KA_DEC);
      u16* va = (u16*)(ws + W_VAT_DEC + i * SZ_KA_DEC);
      ka[((size_t)(b * 2 + kv) * 4608 + 4096 + s) * 64 + d] = f2bf(kvv);
      va[((size_t)(b * 2 + kv) * 64 + d) * 4608 + 4096 + s] = f2bf(vv);
    }
    n = 4ull * 2 * 512 * 8 * 2 * 64;
    for (size_t idx = gtid; idx < n; idx += gsz) {
      int d = idx & 63, m = (idx >> 6) & 1, hd = (idx >> 7) & 7, s = (idx >> 10) & 511, i = (idx >> 19) & 1, b = (int)(idx >> 20);
      u16* kc = (u16*)(ws + W_KC_DEC + i * SZ_KC_DEC);
      kc[(((size_t)(b * 8 + hd) * 2 + m) * 4608 + 4096 + s) * 64 + d] = f2bf(P.in[I_CCK][idx]);
    }
    for (size_t idx = gtid; idx < n; idx += gsz) {
      int dv = idx & 127, hd = (idx >> 7) & 7, s = (idx >> 10) & 511, i = (idx >> 19) & 1, b = (int)(idx >> 20);
      u16* vc = (u16*)(ws + W_VCT_DEC + i * SZ_KC_DEC);
      vc[((size_t)(b * 8 + hd) * 128 + dv) * 4608 + 4096 + s] = f2bf(P.in[I_CCV][idx]);
    }
  }
  if (blockIdx.x == 0) {
    float* rt = (float*)(ws + W_ROPE);
    for (int idx = tid; idx < 64 * 16; idx += 256) {
      int p = idx >> 4, f = idx & 15;
      float freq = powf(10000.0f, -(float)f / 16.0f);
      float ang = (float)p * freq;
      rt[idx * 2] = cosf(ang); rt[idx * 2 + 1] = sinf(ang);
    }
    if (tid < 2) {
      float s1 = 0, s2 = 0;
      for (int k = 0; k < 64; ++k) {
        s1 += P.in[I_LQ1][tid * 64 + k] * P.in[I_LK1][tid * 64 + k];
        s2 += P.in[I_LQ2][tid * 64 + k] * P.in[I_LK2][tid * 64 + k];
      }
      ((float*)(ws + W_LAM))[tid] = expf(s1) - expf(s2) + P.lam_init[tid];
      float ga = 0, gk = 0, gc = 0, gck = 0;
      for (int k = 0; k < 64; ++k) {
        ga = fmaxf(ga, fabsf(P.in[I_AQN][tid * 64 + k])); gk = fmaxf(gk, fabsf(P.in[I_AKN][tid * 64 + k]));
        gc = fmaxf(gc, fabsf(P.in[I_CQN][tid * 64 + k])); gck = fmaxf(gck, fabsf(P.in[I_CKN][tid * 64 + k]));
      }
      float ma = 64.f * ga * gk * QSCALE * 1.03f + 0.01f;
      for (int k = 0; k < 8; ++k) ma = fmaxf(ma, P.in[I_ASINK][tid * 8 + k] * LOG2E);
      ((float*)(ws + W_LAM))[2 + tid] = ma;
      ((float*)(ws + W_LAM))[4 + tid] = 64.f * gc * gck * QSCALE * 1.03f + 0.01f;
    }
  }
}

DI void modnorm_row_write(const Params& P, int l, int which, int t, int lane, const float (&xv)[16]) {
  int isdec, b, s, mi; tokinfo(t, isdec, b, s, mi);
  float ss = 0;
#pragma unroll
  for (int j = 0; j < 16; ++j) ss += xv[j] * xv[j];
  ss = wave_sum(ss);
  float rstd = rsqrtf(ss * (1.f / 1024.f) + EPS);
  const float* g = P.in[which ? I_NFG : I_NMG] + l * 1024;
  const float* mod = (const float*)(P.ws + W_MOD) + ((size_t)l * 5 + mi) * 6144;
  const float* sc = mod + (which ? 4 : 1) * 1024;
  const float* sh = mod + (which ? 3 : 0) * 1024;
  u16* h = (u16*)(P.ws + W_H) + (size_t)t * 1024;
#pragma unroll
  for (int j = 0; j < 4; ++j) {
    int c = j * 256 + lane * 4;
    f32x4 gv = *(const f32x4*)(g + c), scv = *(const f32x4*)(sc + c), shv = *(const f32x4*)(sh + c);
    float o0 = xv[j * 4 + 0] * rstd * gv.x * (1.f + scv.x) + shv.x;
    float o1 = xv[j * 4 + 1] * rstd * gv.y * (1.f + scv.y) + shv.y;
    float o2 = xv[j * 4 + 2] * rstd * gv.z * (1.f + scv.z) + shv.z;
    float o3 = xv[j * 4 + 3] * rstd * gv.w * (1.f + scv.w) + shv.w;
    u32x2 o = {pk2(o0, o1), pk2(o2, o3)};
    *(u32x2*)(h + c) = o;
  }
}
DI void modnorm_phase(const Params& P, int l, int which) {
  const int lane = threadIdx.x & 63, wave = threadIdx.x >> 6;
  const bool from_in = (l == 0 && which == 0);
  const int stride = gridDim.x * 4;
  for (int t = blockIdx.x * 4 + wave; t < NTOK; t += 2 * stride) {
    const int t2 = t + stride;
    const bool has2 = t2 < NTOK;
    const int t2c = has2 ? t2 : t;
    const float* xrow = from_in ? ((t < NCTX) ? P.in[I_XP] + (size_t)t * 1024 : P.in[I_XS] + (size_t)(t - NCTX) * 1024) : P.out + O_X + (size_t)t * 1024;
    const float* xrow2 = from_in ? ((t2c < NCTX) ? P.in[I_XP] + (size_t)t2c * 1024 : P.in[I_XS] + (size_t)(t2c - NCTX) * 1024) : P.out + O_X + (size_t)t2c * 1024;
    float xv[16], xw[16];
#pragma unroll
    for (int j = 0; j < 4; ++j) {
      f32x4 v = *(const f32x4*)(xrow + j * 256 + lane * 4);
      f32x4 w = *(const f32x4*)(xrow2 + j * 256 + lane * 4);
      xv[j * 4] = v.x; xv[j * 4 + 1] = v.y; xv[j * 4 + 2] = v.z; xv[j * 4 + 3] = v.w;
      xw[j * 4] = w.x; xw[j * 4 + 1] = w.y; xw[j * 4 + 2] = w.z; xw[j * 4 + 3] = w.w;
    }
    modnorm_row_write(P, l, which, t, lane, xv);
    if (has2) modnorm_row_write(P, l, which, t2, lane, xw);
  }
}

template <class Epi>
DI void gemm_phase(const u16* __restrict__ A, const u16* __restrict__ Wt, int n_tiles, Epi epi, char* smem) {
  constexpr int BK = 64, LDK = 72, NKT = 1024 / BK;
  constexpr int A_ELEMS = 256 * LDK, B_ELEMS = 128 * LDK, STAGE = A_ELEMS + B_ELEMS;
  const int tid = threadIdx.x, lane = tid & 63, wave = tid >> 6;
  const int wm = wave >> 1, wn = wave & 1, r = lane & 31, h = lane >> 5;
  u16* sbase = (u16*)smem;
  float* sC = (float*)smem;
  const int crw = tid >> 3, ckc = (tid & 7) * 8;
  const int xcd = blockIdx.x & 7, nloc = gridDim.x >> 3;
  for (int q = blockIdx.x >> 3; q < 12 * n_tiles; q += nloc) {
    const int mt = xcd * 12 + q / n_tiles, nt = q % n_tiles;
    const u16* Ab = A + (size_t)mt * 256 * 1024 + (size_t)crw * 1024 + ckc;
    const u16* Bb = Wt + (size_t)nt * 128 * 1024 + (size_t)crw * 1024 + ckc;
    f32x16 acc[4][2];
#pragma unroll
    for (int i = 0; i < 4; ++i)
#pragma unroll
      for (int j = 0; j < 2; ++j)
#pragma unroll
        for (int g = 0; g < 16; ++g) acc[i][j][g] = 0.f;
    u32x4 ra[8], rb[4];
#pragma unroll
    for (int j = 0; j < 8; ++j) ra[j] = *(const u32x4*)(Ab + (size_t)j * 32 * 1024);
#pragma unroll
    for (int j = 0; j < 4; ++j) rb[j] = *(const u32x4*)(Bb + (size_t)j * 32 * 1024);
#pragma unroll
    for (int j = 0; j < 8; ++j) *(u32x4*)(sbase + (crw + 32 * j) * LDK + ckc) = ra[j];
#pragma unroll
    for (int j = 0; j < 4; ++j) *(u32x4*)(sbase + A_ELEMS + (crw + 32 * j) * LDK + ckc) = rb[j];
#pragma unroll
    for (int j = 0; j < 8; ++j) ra[j] = *(const u32x4*)(Ab + (size_t)j * 32 * 1024 + BK);
#pragma unroll
    for (int j = 0; j < 4; ++j) rb[j] = *(const u32x4*)(Bb + (size_t)j * 32 * 1024 + BK);
    __syncthreads();
    for (int kt = 0; kt < NKT; ++kt) {
      const u16* sA = sbase + (kt & 1) * STAGE;
      const u16* sB = sA + A_ELEMS;
      u16* sAn = sbase + ((kt & 1) ^ 1) * STAGE;
      u16* sBn = sAn + A_ELEMS;
#pragma unroll
      for (int ks = 0; ks < 4; ++ks) {
        bf16x8 a[4], b[2];
#pragma unroll
        for (int i = 0; i < 4; ++i) a[i] = ld8(sA + (wm * 128 + i * 32 + r) * LDK + ks * 16 + h * 8);
#pragma unroll
        for (int j = 0; j < 2; ++j) b[j] = ld8(sB + (wn * 64 + j * 32 + r) * LDK + ks * 16 + h * 8);
#pragma unroll
        for (int i = 0; i < 4; ++i)
#pragma unroll
          for (int j = 0; j < 2; ++j) acc[i][j] = MFMA(a[i], b[j], acc[i][j]);
        if (ks == 0 && kt + 1 < NKT) {
#pragma unroll
          for (int j = 0; j < 8; ++j) *(u32x4*)(sAn + (crw + 32 * j) * LDK + ckc) = ra[j];
#pragma unroll
          for (int j = 0; j < 4; ++j) *(u32x4*)(sBn + (crw + 32 * j) * LDK + ckc) = rb[j];
          if (kt + 2 < NKT) {
#pragma unroll
            for (int j = 0; j < 8; ++j) ra[j] = *(const u32x4*)(Ab + (size_t)j * 32 * 1024 + (kt + 2) * BK);
#pragma unroll
            for (int j = 0; j < 4; ++j) rb[j] = *(const u32x4*)(Bb + (size_t)j * 32 * 1024 + (kt + 2) * BK);
          }
        }
      }
      __syncthreads();
    }
#pragma unroll
    for (int i = 0; i < 4; ++i)
#pragma unroll
      for (int j = 0; j < 2; ++j)
#pragma unroll
        for (int g = 0; g < 16; ++g)
          sC[(wm * 128 + i * 32 + crow(g, h)) * 129 + wn * 64 + j * 32 + r] = acc[i][j][g];
    __syncthreads();
    epi(mt * 2, nt, sC);
    epi(mt * 2 + 1, nt, sC + 128 * 129);
    __syncthreads();
  }
}

DI void load32(const float* sC, int base, float (&v)[32]) {
#pragma unroll
  for (int j = 0; j < 32; ++j) v[j] = sC[base + j];
}
DI void headnorm_rope32(float (&v)[32], int a, const float* __restrict__ gain, bool rope, int s, const float* __restrict__ rt, float scale) {
  float ss = 0;
#pragma unroll
  for (int d = 0; d < 32; ++d) ss += v[d] * v[d];
  ss += __shfl_xor(ss, 1);
  float rstd = rsqrtf(ss * (1.f / 64.f) + EPS);
#pragma unroll
  for (int d = 0; d < 32; ++d) v[d] = v[d] * rstd * gain[a * 32 + d];
  if (rope) {
    const float* tb = rt + (a == 0 ? (s >> 6) : (s & 63)) * 32;
#pragma unroll
    for (int f = 0; f < 16; ++f) {
      float cs = tb[f * 2], sn = tb[f * 2 + 1];
      float x1 = v[f], x2 = v[16 + f];
      v[f] = x1 * cs - x2 * sn;
      v[16 + f] = x2 * cs + x1 * sn;
    }
  }
#pragma unroll
  for (int d = 0; d < 32; ++d) v[d] *= scale;
}
DI void store32_bf16(u16* dst, const float (&v)[32]) {
#pragma unroll
  for (int j = 0; j < 4; ++j) {
    u32x4 o = {pk2(v[j * 8], v[j * 8 + 1]), pk2(v[j * 8 + 2], v[j * 8 + 3]), pk2(v[j * 8 + 4], v[j * 8 + 5]), pk2(v[j * 8 + 6], v[j * 8 + 7])};
    *(u32x4*)(dst + j * 8) = o;
  }
}
DI void store32_f32(float* dst, const float (&v)[32]) {
#pragma unroll
  for (int j = 0; j < 8; ++j) {
    f32x4 o = {v[j * 4], v[j * 4 + 1], v[j * 4 + 2], v[j * 4 + 3]};
    *(f32x4*)(dst + j * 4) = o;
  }
}

struct EpiEvenIn {
  const Params* P; int i;
  DI void operator()(int mt, int nt, const float* sC) const {
    const Params& p = *P; char* ws = p.ws;
    const int tid = threadIdx.x;
    const int t0 = mt * 128;
    int isdec, b, s0, mi; tokinfo(t0, isdec, b, s0, mi);
    const float* rt = (const float*)(ws + W_ROPE);
    if (nt == 5) {
      const int c = tid & 127, tg = tid >> 7, kv = c >> 6, d = c & 63;
#pragma unroll 1
      for (int q = 0; q < 2; ++q) {
        const int tk = (q * 2 + tg) * 32;
        float v[32];
#pragma unroll
        for (int j = 0; j < 32; ++j) v[j] = sC[(tk + j) * 129 + c];
        const int s = s0 + tk;
        if (isdec) {
          store32_bf16((u16*)(ws + W_VAT_DEC + i * SZ_KA_DEC) + ((size_t)(b * 2 + kv) * 64 + d) * 4608 + s, v);
        } else {
          store32_bf16((u16*)(ws + W_VAT_CTX) + ((size_t)(b * 2 + kv) * 64 + d) * 256 + s, v);
          float* o = p.out + O_CAV + ((((size_t)b * 2 + i) * 256 + s) * 2 + kv) * 64 + d;
#pragma unroll
          for (int j = 0; j < 32; ++j) o[(size_t)j * 128] = v[j];
        }
      }
      return;
    }
    const int row = tid >> 1, a = tid & 1;
    const int t = t0 + row, s = s0 + row;
#pragma unroll 1
    for (int seg = 0; seg < 2; ++seg) {
      if (nt == 18 && seg == 1) break;
      float v[32];
      load32(sC, row * 129 + seg * 64 + a * 32, v);
      if (nt < 4) {
        int head = nt * 2 + seg;
        headnorm_rope32(v, a, p.in[I_AQN] + i * 64, isdec, s, rt, QSCALE);
        store32_bf16((u16*)(ws + W_Q) + (size_t)t * 1024 + head * 64 + a * 32, v);
      } else if (nt == 4) {
        int kv = seg;
        headnorm_rope32(v, a, p.in[I_AKN] + i * 64, isdec, s, rt, 1.f);
        if (isdec) {
          store32_bf16((u16*)(ws + W_KA_DEC + i * SZ_KA_DEC) + ((size_t)(b * 2 + kv) * 4608 + s) * 64 + a * 32, v);
        } else {
          store32_bf16((u16*)(ws + W_KA_CTX) + ((size_t)(b * 2 + kv) * 256 + s) * 64 + a * 32, v);
          store32_f32(p.out + O_CAK + ((((size_t)b * 2 + i) * 256 + s) * 2 + kv) * 64 + a * 32, v);
        }
      } else if (nt < 8) {
#pragma unroll
        for (int j = 0; j < 32; ++j) v[j] *= 0.125f;
        store32_bf16((u16*)(ws + W_BQ) + (size_t)t * 256 + (nt - 6) * 128 + seg * 64 + a * 32, v);
      } else if (nt < 10) {
        store32_bf16((u16*)(ws + W_BK) + (size_t)t * 256 + (nt - 8) * 128 + seg * 64 + a * 32, v);
      } else if (nt < 14) {
        store32_bf16((u16*)(ws + W_BV) + (size_t)t * 512 + (nt - 10) * 128 + seg * 64 + a * 32, v);
      } else if (nt < 18) {
        store32_bf16((u16*)(ws + W_BR) + (size_t)t * 512 + (nt - 14) * 128 + seg * 64 + a * 32, v);
      } else {
        if (a == 0) store32_f32((float*)(ws + W_BG) + (size_t)t * 32, v);
      }
    }
  }
};

struct EpiOddIn {
  const Params* P; int i;
  DI void operator()(int mt, int nt, const float* sC) const {
    const Params& p = *P; char* ws = p.ws;
    const int tid = threadIdx.x;
    const int t0 = mt * 128;
    int isdec, b, s0, mi; tokinfo(t0, isdec, b, s0, mi);
    const float* rt = (const float*)(ws + W_ROPE);
    if (nt >= 16) {
      const int c = tid & 127, tg = tid >> 7, hd = nt - 16;
#pragma unroll 1
      for (int q = 0; q < 2; ++q) {
        const int tk = (q * 2 + tg) * 32;
        float v[32];
#pragma unroll
        for (int j = 0; j < 32; ++j) v[j] = sC[(tk + j) * 129 + c];
        const int s = s0 + tk;
        if (isdec) {
          store32_bf16((u16*)(ws + W_VCT_DEC + i * SZ_KC_DEC) + ((size_t)(b * 8 + hd) * 128 + c) * 4608 + s, v);
        } else {
          store32_bf16((u16*)(ws + W_VCT_CTX) + ((size_t)(b * 8 + hd) * 128 + c) * 256 + s, v);
          float* o = p.out + O_CCV + ((((size_t)b * 2 + i) * 256 + s) * 8 + hd) * 128 + c;
#pragma unroll
          for (int j = 0; j < 32; ++j) o[(size_t)j * 1024] = v[j];
        }
      }
      return;
    }
    const int row = tid >> 1, a = tid & 1;
    const int t = t0 + row, s = s0 + row;
#pragma unroll 1
    for (int seg = 0; seg < 2; ++seg) {
      float v[32];
      load32(sC, row * 129 + seg * 64 + a * 32, v);
      if (nt < 8) {
        headnorm_rope32(v, a, p.in[I_CQN] + i * 64, isdec, s, rt, QSCALE);
        store32_bf16((u16*)(ws + W_Q) + (size_t)t * 1024 + nt * 128 + seg * 64 + a * 32, v);
      } else {
        int hd = nt - 8, m = seg;
        headnorm_rope32(v, a, p.in[I_CKN] + i * 64, isdec, s, rt, 1.f);
        if (isdec) {
          store32_bf16((u16*)(ws + W_KC_DEC + i * SZ_KC_DEC) + (((size_t)(b * 8 + hd) * 2 + m) * 4608 + s) * 64 + a * 32, v);
        } else {
          store32_bf16((u16*)(ws + W_KC_CTX) + (((size_t)(b * 8 + hd) * 2 + m) * 256 + s) * 64 + a * 32, v);
          store32_f32(p.out + O_CCK + (((((size_t)b * 2 + i) * 256 + s) * 8 + hd) * 2 + m) * 64 + a * 32, v);
        }
      }
    }
  }
};

struct EpiOut {
  const Params* P; int l;
  DI void operator()(int mt, int nt, const float* sC) const {
    const Params& p = *P;
    const int tid = threadIdx.x;
    const int t0 = mt * 128;
    int isdec, b, s0, mi; tokinfo(t0, isdec, b, s0, mi);
    const int c = (tid & 31) * 4;
    const float* g1 = (const float*)(p.ws + W_MOD) + ((size_t)l * 5 + mi) * 6144 + 2 * 1024 + nt * 128 + c;
    f32x4 gv = *(const f32x4*)g1;
    float* x = p.out + O_X;
    const float* xin = (l != 0) ? (const float*)x : ((t0 < NCTX) ? p.in[I_XP] : p.in[I_XS] - (size_t)NCTX * 1024);
#pragma unroll
    for (int j = 0; j < 16; ++j) {
      int row = (tid >> 5) + 8 * j;
      f32x4* xp = (f32x4*)(x + (size_t)(t0 + row) * 1024 + nt * 128 + c);
      f32x4 xv = *(const f32x4*)(xin + (size_t)(t0 + row) * 1024 + nt * 128 + c);
      const float* cc = sC + row * 129 + c;
      xv.x += gv.x * cc[0]; xv.y += gv.y * cc[1]; xv.z += gv.z * cc[2]; xv.w += gv.w * cc[3];
      *xp = xv;
    }
  }
};

struct EpiPQ {
  const Params* P;
  DI void operator()(int mt, int nt, const float* sC) const {
    const int tid = threadIdx.x;
    const int c = (tid & 31) * 4;
    u16* q = (u16*)(P->ws + W_Q);
#pragma unroll
    for (int j = 0; j < 16; ++j) {
      int row = (tid >> 5) + 8 * j;
      const float* cc = sC + row * 129 + c;
      u32x2 o = {pk2(cc[0], cc[1]), pk2(cc[2], cc[3])};
      *(u32x2*)(q + (size_t)(mt * 128 + row) * 1024 + nt * 128 + c) = o;
    }
  }
};

template <int DV, bool DIFF, int QG>
DI void attn_item(const u16* __restrict__ Qb  , const u16* __restrict__ Kb, size_t kmap_stride,
                  const u16* __restrict__ VT, int vt_stride, int ta0, int ta1, int tb0, int tb1, bool window, int qpos0,
                  float Mb, float sinkp, float lam, const float* __restrict__ onorm, float oscale,
                  u16* __restrict__ Ob  , char* smem) {
  constexpr int RB = DV / 32;
  constexpr int KMAPS = DIFF ? 2 : 1;
  constexpr int KBUF = KMAPS * 64 * 72, VBUF = DV * 72;
  const int tid = threadIdx.x, lane = tid & 63, wave = tid >> 6, r = lane & 31, h = lane >> 5;
  const int mw = DIFF ? (wave >> 1) : 0;
  const int qrow0 = DIFF ? ((wave & 1) * QG * 32 + r) : (wave * QG * 32 + r);
  u16* sK = (u16*)smem;
  u16* sV = sK + 2 * KBUF;
  const int c0 = tid, c1 = tid + 256, c2 = tid + 512, c3 = tid + 768;
  bf16x8 qf[QG][4];
#pragma unroll
  for (int qg = 0; qg < QG; ++qg)
#pragma unroll
    for (int ks = 0; ks < 4; ++ks) qf[qg][ks] = ld8(Qb + (size_t)(qrow0 + qg * 32) * 1024 + mw * 64 + ks * 16 + h * 8);
  f32x16 acc[QG][RB];
  float lrun[QG];
#pragma unroll
  for (int qg = 0; qg < QG; ++qg) {
#pragma unroll
    for (int rb = 0; rb < RB; ++rb)
#pragma unroll
      for (int g = 0; g < 16; ++g) acc[qg][rb][g] = 0.f;
    lrun[qg] = (h == 0) ? sinkp : 0.f;
  }
  const int na = ta1 - ta0, ntl = na + (tb1 - tb0);
  u32x4 st0, st1, st2, st3;
  {
    const int tile = (0 < na) ? ta0 : tb0;
    const u16* kp = Kb + (size_t)tile * 64 * 64;
    st0 = *(const u32x4*)(kp + (size_t)(c0 >> 3) * 64 + (c0 & 7) * 8);
    st1 = *(const u32x4*)(kp + (size_t)(c1 >> 3) * 64 + (c1 & 7) * 8);
    if (KMAPS > 1) {
      st2 = *(const u32x4*)(kp + kmap_stride + (size_t)(c0 >> 3) * 64 + (c0 & 7) * 8);
      st3 = *(const u32x4*)(kp + kmap_stride + (size_t)(c1 >> 3) * 64 + (c1 & 7) * 8);
    }
    *(u32x4*)(sK + (c0 >> 3) * 72 + (c0 & 7) * 8) = st0;
    *(u32x4*)(sK + (c1 >> 3) * 72 + (c1 & 7) * 8) = st1;
    if (KMAPS > 1) {
      *(u32x4*)(sK + 64 * 72 + (c0 >> 3) * 72 + (c0 & 7) * 8) = st2;
      *(u32x4*)(sK + 64 * 72 + (c1 >> 3) * 72 + (c1 & 7) * 8) = st3;
    }
    const u16* vp = VT + (size_t)tile * 64;
    st0 = *(const u32x4*)(vp + (size_t)(c0 >> 3) * vt_stride + (c0 & 7) * 8);
    st1 = *(const u32x4*)(vp + (size_t)(c1 >> 3) * vt_stride + (c1 & 7) * 8);
    if (DV > 64) {
      st2 = *(const u32x4*)(vp + (size_t)(c2 >> 3) * vt_stride + (c2 & 7) * 8);
      st3 = *(const u32x4*)(vp + (size_t)(c3 >> 3) * vt_stride + (c3 & 7) * 8);
    }
    *(u32x4*)(sV + (c0 >> 3) * 72 + (c0 & 7) * 8) = st0;
    *(u32x4*)(sV + (c1 >> 3) * 72 + (c1 & 7) * 8) = st1;
    if (DV > 64) {
      *(u32x4*)(sV + (c2 >> 3) * 72 + (c2 & 7) * 8) = st2;
      *(u32x4*)(sV + (c3 >> 3) * 72 + (c3 & 7) * 8) = st3;
    }
  }
  for (int it = 0; it < ntl; ++it) {
    const int tile = (it < na) ? (ta0 + it) : (tb0 + it - na);
    const int cur = it & 1, nxt = cur ^ 1;
    const bool more = (it + 1 < ntl);
    const int ntile = (it + 1 < na) ? (ta0 + it + 1) : (tb0 + it + 1 - na);
    const u16* sKc = sK + cur * KBUF + mw * 64 * 72;
    const u16* sVc = sV + cur * VBUF;
    __syncthreads();
    if (more) {
      const u16* kp = Kb + (size_t)ntile * 64 * 64;
      st0 = *(const u32x4*)(kp + (size_t)(c0 >> 3) * 64 + (c0 & 7) * 8);
      st1 = *(const u32x4*)(kp + (size_t)(c1 >> 3) * 64 + (c1 & 7) * 8);
      if (KMAPS > 1) {
        st2 = *(const u32x4*)(kp + kmap_stride + (size_t)(c0 >> 3) * 64 + (c0 & 7) * 8);
        st3 = *(const u32x4*)(kp + kmap_stride + (size_t)(c1 >> 3) * 64 + (c1 & 7) * 8);
      }
    }
    const bool domask = window && (it < na);
    f32x16 s[QG][2];
#pragma unroll
    for (int kb = 0; kb < 2; ++kb) {
#pragma unroll
      for (int qg = 0; qg < QG; ++qg)
#pragma unroll
        for (int g = 0; g < 16; ++g) s[qg][kb][g] = -Mb;
#pragma unroll
      for (int ks = 0; ks < 4; ++ks) {
        bf16x8 a = ld8(sKc + (kb * 32 + pi32(r)) * 72 + ks * 16 + h * 8);
#pragma unroll
        for (int qg = 0; qg < QG; ++qg) s[qg][kb] = MFMA(a, qf[qg][ks], s[qg][kb]);
      }
    }
    bf16x8 pf[QG][2][2];
#pragma unroll
    for (int qg = 0; qg < QG; ++qg) {
      if (domask) {
        const int qpos = qpos0 + qrow0 + qg * 32;
#pragma unroll
        for (int kb = 0; kb < 2; ++kb)
#pragma unroll
          for (int g = 0; g < 16; ++g) {
            int kpos = tile * 64 + kb * 32 + 16 * (g >> 3) + 8 * h + (g & 7);
            int dlt = qpos - kpos;
            if (dlt > 128 || dlt < -128) s[qg][kb][g] = -INFINITY;
          }
      }
      float ls = 0.f;
#pragma unroll
      for (int kb = 0; kb < 2; ++kb)
#pragma unroll
        for (int g = 0; g < 16; ++g) { float pv = __builtin_amdgcn_exp2f(s[qg][kb][g]); s[qg][kb][g] = pv; ls += pv; }
      lrun[qg] += ls;
#pragma unroll
      for (int kb = 0; kb < 2; ++kb)
#pragma unroll
        for (int s2 = 0; s2 < 2; ++s2) {
          u32x4 u = {pk2(s[qg][kb][8 * s2], s[qg][kb][8 * s2 + 1]), pk2(s[qg][kb][8 * s2 + 2], s[qg][kb][8 * s2 + 3]),
                     pk2(s[qg][kb][8 * s2 + 4], s[qg][kb][8 * s2 + 5]), pk2(s[qg][kb][8 * s2 + 6], s[qg][kb][8 * s2 + 7])};
          pf[qg][kb][s2] = __builtin_bit_cast(bf16x8, u);
        }
    }
    if (more) {
      u16* sKn = sK + nxt * KBUF;
      *(u32x4*)(sKn + (c0 >> 3) * 72 + (c0 & 7) * 8) = st0;
      *(u32x4*)(sKn + (c1 >> 3) * 72 + (c1 & 7) * 8) = st1;
      if (KMAPS > 1) {
        *(u32x4*)(sKn + 64 * 72 + (c0 >> 3) * 72 + (c0 & 7) * 8) = st2;
        *(u32x4*)(sKn + 64 * 72 + (c1 >> 3) * 72 + (c1 & 7) * 8) = st3;
      }
      const u16* vp = VT + (size_t)ntile * 64;
      st0 = *(const u32x4*)(vp + (size_t)(c0 >> 3) * vt_stride + (c0 & 7) * 8);
      st1 = *(const u32x4*)(vp + (size_t)(c1 >> 3) * vt_stride + (c1 & 7) * 8);
      if (DV > 64) {
        st2 = *(const u32x4*)(vp + (size_t)(c2 >> 3) * vt_stride + (c2 & 7) * 8);
        st3 = *(const u32x4*)(vp + (size_t)(c3 >> 3) * vt_stride + (c3 & 7) * 8);
      }
    }
#pragma unroll
    for (int rb = 0; rb < RB; ++rb)
#pragma unroll
      for (int kb = 0; kb < 2; ++kb)
#pragma unroll
        for (int s2 = 0; s2 < 2; ++s2) {
          bf16x8 v = ld8(sVc + (rb * 32 + r) * 72 + kb * 32 + s2 * 16 + h * 8);
#pragma unroll
          for (int qg = 0; qg < QG; ++qg) acc[qg][rb] = MFMA(v, pf[qg][kb][s2], acc[qg][rb]);
        }
    if (more) {
      u16* sVn = sV + nxt * VBUF;
      *(u32x4*)(sVn + (c0 >> 3) * 72 + (c0 & 7) * 8) = st0;
      *(u32x4*)(sVn + (c1 >> 3) * 72 + (c1 & 7) * 8) = st1;
      if (DV > 64) {
        *(u32x4*)(sVn + (c2 >> 3) * 72 + (c2 & 7) * 8) = st2;
        *(u32x4*)(sVn + (c3 >> 3) * 72 + (c3 & 7) * 8) = st3;
      }
    }
  }
  float inv[QG];
#pragma unroll
  for (int qg = 0; qg < QG; ++qg) { const float lt = lrun[qg] + __shfl_xor(lrun[qg], 32); inv[qg] = 1.f / lt; }
  if (!DIFF) {
#pragma unroll
    for (int qg = 0; qg < QG; ++qg) {
      u16* orow = Ob + (size_t)(qrow0 + qg * 32) * 1024;
#pragma unroll
      for (int rb = 0; rb < RB; ++rb)
#pragma unroll
        for (int g4 = 0; g4 < 4; ++g4) {
          u32x2 o = {pk2(acc[qg][rb][g4 * 4] * inv[qg], acc[qg][rb][g4 * 4 + 1] * inv[qg]),
                     pk2(acc[qg][rb][g4 * 4 + 2] * inv[qg], acc[qg][rb][g4 * 4 + 3] * inv[qg])};
          *(u32x2*)(orow + rb * 32 + 8 * g4 + 4 * h) = o;
        }
    }
    __syncthreads();
  } else {
    float* sX = (float*)smem;
    __syncthreads();
    if (mw == 1) {
#pragma unroll
      for (int qg = 0; qg < QG; ++qg) {
        const float c1f = lam * inv[qg];
#pragma unroll
        for (int rb = 0; rb < RB; ++rb)
#pragma unroll
          for (int g = 0; g < 16; ++g) sX[((((wave & 1) * QG + qg) * RB + rb) * 16 + g) * 64 + lane] = acc[qg][rb][g] * c1f;
      }
    }
    __syncthreads();
    if (mw == 0) {
#pragma unroll
      for (int qg = 0; qg < QG; ++qg) {
        float ss = 0.f;
#pragma unroll
        for (int rb = 0; rb < RB; ++rb)
#pragma unroll
          for (int g = 0; g < 16; ++g) {
            float o = acc[qg][rb][g] * inv[qg] - sX[((((wave & 1) * QG + qg) * RB + rb) * 16 + g) * 64 + lane];
            acc[qg][rb][g] = o; ss += o * o;
          }
        ss += __shfl_xor(ss, 32);
        const float rstd = rsqrtf(ss * (1.f / DV) + EPS) * oscale;
        u16* orow = Ob + (size_t)(qrow0 + qg * 32) * 1024;
#pragma unroll
        for (int rb = 0; rb < RB; ++rb)
#pragma unroll
          for (int g4 = 0; g4 < 4; ++g4) {
            int dv = rb * 32 + 8 * g4 + 4 * h;
            f32x4 gn = *(const f32x4*)(onorm + dv);
            u32x2 o = {pk2(acc[qg][rb][g4 * 4] * rstd * gn.x, acc[qg][rb][g4 * 4 + 1] * rstd * gn.y),
                       pk2(acc[qg][rb][g4 * 4 + 2] * rstd * gn.z, acc[qg][rb][g4 * 4 + 3] * rstd * gn.w)};
            *(u32x2*)(orow + dv) = o;
          }
      }
    }
    __syncthreads();
  }
}

DI void attnA_item(const Params& P, int i, int item, char* smem) {
  char* ws = P.ws;
  const u16* Q = (const u16*)(ws + W_Q);
  u16* O = (u16*)(ws + W_OMIX);
  int t0, head, ta0, ta1, tb0, tb1, vts, qpos0; bool window;
  const u16* Kb; const u16* VT;
  if (item < 512) {
    int n = item & 15, b = item >> 7; head = (item >> 4) & 7;
    int kv = head >> 2;
    t0 = NCTX + b * 4096 + n * 256;
    Kb = (const u16*)(ws + W_KA_DEC + i * SZ_KA_DEC) + (size_t)(b * 2 + kv) * 4608 * 64;
    VT = (const u16*)(ws + W_VAT_DEC + i * SZ_KA_DEC) + (size_t)(b * 2 + kv) * 64 * 4608;
    ta0 = max(0, 4 * n - 2); ta1 = min(64, 4 * n + 6); tb0 = 64; tb1 = 72; vts = 4608; window = true; qpos0 = n * 256;
  } else {
    int it = item - 512;
    int b = it >> 3; head = it & 7;
    int kv = head >> 2;
    t0 = b * 256;
    Kb = (const u16*)(ws + W_KA_CTX) + (size_t)(b * 2 + kv) * 256 * 64;
    VT = (const u16*)(ws + W_VAT_CTX) + (size_t)(b * 2 + kv) * 64 * 256;
    ta0 = 0; ta1 = 4; tb0 = 0; tb1 = 0; vts = 256; window = false; qpos0 = 0;
  }
  float Mb = ((const float*)(ws + W_LAM))[2 + i];
  float sinkp = __builtin_amdgcn_exp2f(P.in[I_ASINK][i * 8 + head] * LOG2E - Mb);
  attn_item<64, false, 2>(Q + (size_t)t0 * 1024 + head * 64, Kb, 0, VT, vts, ta0, ta1, tb0, tb1, window, qpos0, Mb, sinkp, 0.f, nullptr, 1.f,
                          O + (size_t)t0 * 1024 + head * 64, smem);
}
DI void attnC_phase(const Params& P, int i, char* smem) {
  char* ws = P.ws;
  const u16* Q = (const u16*)(ws + W_Q);
  u16* O = (u16*)(ws + W_OMIX);
  const float lam = ((const float*)(ws + W_LAM))[i];
  const float oscale = 1.f - P.lam_init[i];
  const float* onorm = P.in[I_CON] + i * 128;
  const float Mb = ((const float*)(ws + W_LAM))[4 + i];
  const int xcd = blockIdx.x & 7, local = blockIdx.x >> 3, nloc = gridDim.x >> 3;
  for (int q = local; q < 4 * 32 + 64; q += nloc) {
    int t0, head, nt, tk;
    const u16* Kb; const u16* VT;
    if (q < 128) {
      const int pair = xcd + 8 * (q >> 5), n = q & 31, b = pair >> 3; head = pair & 7;
      t0 = NCTX + b * 4096 + n * 128;
      Kb = (const u16*)(ws + W_KC_DEC + i * SZ_KC_DEC) + (size_t)(b * 8 + head) * 2 * 4608 * 64;
      VT = (const u16*)(ws + W_VCT_DEC + i * SZ_KC_DEC) + (size_t)(b * 8 + head) * 128 * 4608;
      nt = 72; tk = 4608;
    } else {
      const int it = q - 128;
      const int pair = xcd + 8 * (it >> 1), n = it & 1, b = pair >> 3; head = pair & 7;
      t0 = b * 256 + n * 128;
      Kb = (const u16*)(ws + W_KC_CTX) + (size_t)(b * 8 + head) * 2 * 256 * 64;
      VT = (const u16*)(ws + W_VCT_CTX) + (size_t)(b * 8 + head) * 128 * 256;
      nt = 4; tk = 256;
    }
    attn_item<128, true, 2>(Q + (size_t)t0 * 1024 + head * 128, Kb, (size_t)tk * 64, VT, tk, 0, nt, 0, 0, false, 0, Mb, 0.f, lam, onorm, oscale,
                            O + (size_t)t0 * 1024 + head * 128, smem);
  }
}

DI float log_sigmoid_f(float z) { return fminf(z, 0.f) - log1pf(__expf(-fabsf(z))); }

DI void gla_gates(const Params& P, int i, int hd, int dir, const float* sBG, float* sB) {
  const int tid = threadIdx.x, d = tid & 63, jq = tid >> 6;
  const float* gw = P.in[dir ? I_GWB : I_GWF] + (size_t)i * 16 * 256 + hd * 64 + d;
  const float gb = P.in[dir ? I_GBB : I_GBF][i * 256 + hd * 64 + d];
  float w[16];
#pragma unroll
  for (int rr = 0; rr < 16; ++rr) w[rr] = gw[rr * 256];
  for (int j = jq * 16; j < jq * 16 + 16; ++j) {
    float z = gb;
#pragma unroll
    for (int rr = 0; rr < 16; ++rr) z += sBG[j * 33 + dir * 16 + rr] * w[rr];
    sB[j * 65 + d] = log_sigmoid_f(z) * (1.f / 16.f);
  }
  __syncthreads();
  if (tid < 64) {
    float run = 0.f;
    if (dir == 0) { for (int j = 0; j < 64; ++j) { run += sB[j * 65 + tid]; sB[j * 65 + tid] = run; } }
    else { for (int j = 63; j >= 0; --j) { run += sB[j * 65 + tid]; sB[j * 65 + tid] = run; } }
  }
  __syncthreads();
}
DI void gla_load_common(const Params& P, int t0, int hd, float* sBG, u16* sVT) {
  const int tid = threadIdx.x;
  const float* bg = (const float*)(P.ws + W_BG) + (size_t)t0 * 32;
  for (int idx = tid; idx < 2048; idx += 256) sBG[(idx >> 5) * 33 + (idx & 31)] = bg[idx];
  {
    int j = tid & 63, vg = tid >> 6;
    const u16* src = (const u16*)(P.ws + W_BV) + (size_t)(t0 + j) * 512 + hd * 128 + vg * 32;
#pragma unroll
    for (int q = 0; q < 4; ++q) {
      u32x4 u = *(const u32x4*)(src + q * 8);
      unsigned w4[4] = {u.x, u.y, u.z, u.w};
#pragma unroll
      for (int e = 0; e < 4; ++e) {
        sVT[(vg * 32 + q * 8 + e * 2) * 72 + j] = (u16)(w4[e] & 0xffffu);
        sVT[(vg * 32 + q * 8 + e * 2 + 1) * 72 + j] = (u16)(w4[e] >> 16);
      }
    }
  }
}

DI void gla_b1_item(const Params& P, int i, int item, char* smem) {
  const int cgk = item >> 2, hd = item & 3, t0 = cgk * 64;
  const int tid = threadIdx.x, lane = tid & 63, wave = tid >> 6, r = lane & 31, h = lane >> 5;
  u16* sVT = (u16*)smem;
  float* sBG = (float*)(smem + 18432);
  float* sB = (float*)(smem + 18432 + 8448);
  u16* sKT = (u16*)(smem + 18432 + 8448 + 16640);
  gla_load_common(P, t0, hd, sBG, sVT);
  __syncthreads();
  for (int dir = 0; dir < 2; ++dir) {
    gla_gates(P, i, hd, dir, sBG, sB);
    {
      int d = tid & 63, jq = tid >> 6;
      float tot = (dir == 0) ? sB[63 * 65 + d] : sB[d];
      const u16* kp = (const u16*)(P.ws + W_BK) + (size_t)t0 * 256 + hd * 64 + d;
      for (int j = jq * 16; j < jq * 16 + 16; ++j) {
        float kvv = bf2f(kp[(size_t)j * 256]);
        sKT[d * 72 + j] = f2bf(kvv * __expf(tot - sB[j * 65 + d]));
      }
      if (jq == 0) ((float*)(P.ws + W_DEC))[((size_t)item * 2 + dir) * 64 + d] = __expf(tot);
    }
    __syncthreads();
    {
      int dblk = wave >> 1, vh = wave & 1;
      f32x16 acc[2];
#pragma unroll
      for (int jv = 0; jv < 2; ++jv)
#pragma unroll
        for (int g = 0; g < 16; ++g) acc[jv][g] = 0.f;
#pragma unroll
      for (int ks = 0; ks < 4; ++ks) {
        bf16x8 a = ld8(sKT + (dblk * 32 + r) * 72 + ks * 16 + h * 8);
#pragma unroll
        for (int jv = 0; jv < 2; ++jv) {
          bf16x8 bb = ld8(sVT + (vh * 64 + jv * 32 + r) * 72 + ks * 16 + h * 8);
          acc[jv] = MFMA(a, bb, acc[jv]);
        }
      }
      float* kvo = (float*)(P.ws + W_KV) + ((size_t)item * 2 + dir) * 8192;
#pragma unroll
      for (int jv = 0; jv < 2; ++jv)
#pragma unroll
        for (int g = 0; g < 16; ++g) kvo[(dblk * 32 + crow(g, h)) * 128 + vh * 64 + jv * 32 + r] = acc[jv][g];
    }
    __syncthreads();
  }
}

DI void gla_scan_phase(const Params& P, int i) {
  const int tid = threadIdx.x;
  for (int item = blockIdx.x; item < 36 * 4 * 2 * 8; item += gridDim.x) {
    int slab = item & 7, dir = (item >> 3) & 1, hd = (item >> 4) & 3, seq = item >> 6;
    int cg0, NC, b, isdec;
    if (seq < 32) { isdec = 0; b = seq; cg0 = b * 4; NC = 4; } else { isdec = 1; b = seq - 32; cg0 = 128 + b * 64; NC = 64; }
    int e = slab * 1024 + tid * 4, d = e >> 7;
    f32x4 s = {0.f, 0.f, 0.f, 0.f};
    if (isdec) s = *(const f32x4*)(P.in[dir ? I_SBB : I_SBF] + (((size_t)b * 2 + i) * 4 + hd) * 8192 + e);
    float* kvb = (float*)(P.ws + W_KV);
    const float* decb = (const float*)(P.ws + W_DEC);
    for (int n4 = 0; n4 < NC; n4 += 4) {
      f32x4 tmp[4]; float dc[4];
#pragma unroll
      for (int u = 0; u < 4; ++u) {
        int n = dir ? (NC - 1 - (n4 + u)) : (n4 + u);
        size_t ci = ((size_t)(cg0 + n) * 4 + hd) * 2 + dir;
        tmp[u] = *(const f32x4*)(kvb + ci * 8192 + e);
        dc[u] = decb[ci * 64 + d];
      }
#pragma unroll
      for (int u = 0; u < 4; ++u) {
        int n = dir ? (NC - 1 - (n4 + u)) : (n4 + u);
        size_t ci = ((size_t)(cg0 + n) * 4 + hd) * 2 + dir;
        *(f32x4*)(kvb + ci * 8192 + e) = s;
        s.x = dc[u] * s.x + tmp[u].x; s.y = dc[u] * s.y + tmp[u].y; s.z = dc[u] * s.z + tmp[u].z; s.w = dc[u] * s.w + tmp[u].w;
      }
    }
    if (!isdec) *(f32x4*)(P.out + (dir ? O_SBB : O_SBF) + (((size_t)b * 2 + i) * 4 + hd) * 8192 + e) = s;
  }
}

DI void gla_b3_item(const Params& P, int i, int item, char* smem) {
  const int cgk = item >> 2, hd = item & 3, t0 = cgk * 64;
  const int tid = threadIdx.x, lane = tid & 63, wave = tid >> 6, r = lane & 31, h = lane >> 5;
  u16* sVT = (u16*)smem;
  u16* sA = (u16*)(smem + 18432);
  float* sBG = (float*)(smem + 27648);
  float* sB = (float*)(smem + 36096);
  u16* sQD = (u16*)(smem + 52736);
  u16* sKD = (u16*)(smem + 61952);
  float* sO = (float*)(smem + 36096);
  gla_load_common(P, t0, hd, sBG, sVT);
  __syncthreads();
  const int iblk = wave >> 1, jblk = wave & 1;
  f32x16 aacc[2], oacc[2];
#pragma unroll
  for (int u = 0; u < 2; ++u)
#pragma unroll
    for (int g = 0; g < 16; ++g) { aacc[u][g] = 0.f; oacc[u][g] = 0.f; }
#pragma unroll
  for (int dir = 0; dir < 2; ++dir) {
    gla_gates(P, i, hd, dir, sBG, sB);
    {
      int d = tid & 63, jq = tid >> 6;
      const u16* qp = (const u16*)(P.ws + W_BQ) + (size_t)t0 * 256 + hd * 64 + d;
      const u16* kp = (const u16*)(P.ws + W_BK) + (size_t)t0 * 256 + hd * 64 + d;
      for (int j = jq * 16; j < jq * 16 + 16; ++j) {
        float bb = sB[j * 65 + d];
        sQD[j * 72 + d] = f2bf(bf2f(qp[(size_t)j * 256]) * __expf(bb));
        sKD[j * 72 + d] = f2bf(bf2f(kp[(size_t)j * 256]) * __expf(-bb));
      }
    }
    __syncthreads();
#pragma unroll
    for (int ks = 0; ks < 4; ++ks) {
      bf16x8 a = ld8(sQD + (iblk * 32 + r) * 72 + ks * 16 + h * 8);
      bf16x8 bb = ld8(sKD + (jblk * 32 + r) * 72 + ks * 16 + h * 8);
      aacc[dir] = MFMA(a, bb, aacc[dir]);
    }
    const float* S = (const float*)(P.ws + W_KV) + ((size_t)item * 2 + dir) * 8192 + wave * 32 + r;
#pragma unroll
    for (int ks = 0; ks < 4; ++ks) {
      float sv[8];
#pragma unroll
      for (int jj = 0; jj < 8; ++jj) sv[jj] = S[(size_t)(ks * 16 + h * 8 + jj) * 128];
      u32x4 u = {pk2(sv[0], sv[1]), pk2(sv[2], sv[3]), pk2(sv[4], sv[5]), pk2(sv[6], sv[7])};
      bf16x8 bfr = __builtin_bit_cast(bf16x8, u);
#pragma unroll
      for (int it = 0; it < 2; ++it) {
        bf16x8 a = ld8(sQD + (it * 32 + r) * 72 + ks * 16 + h * 8);
        oacc[it] = MFMA(a, bfr, oacc[it]);
      }
    }
    __syncthreads();
  }
#pragma unroll
  for (int g = 0; g < 16; ++g) {
    int ii = iblk * 32 + crow(g, h), jj = jblk * 32 + r;
    float v = (jj <= ii ? aacc[0][g] : 0.f) + (jj >= ii ? aacc[1][g] : 0.f);
    sA[ii * 72 + jj] = f2bf(v);
  }
  __syncthreads();
#pragma unroll
  for (int ks = 0; ks < 4; ++ks) {
    bf16x8 bb = ld8(sVT + (wave * 32 + r) * 72 + ks * 16 + h * 8);
#pragma unroll
    for (int it = 0; it < 2; ++it) {
      bf16x8 a = ld8(sA + (it * 32 + r) * 72 + ks * 16 + h * 8);
      oacc[it] = MFMA(a, bb, oacc[it]);
    }
  }
#pragma unroll
  for (int it = 0; it < 2; ++it)
#pragma unroll
    for (int g = 0; g < 16; ++g) sO[(it * 32 + crow(g, h)) * 129 + wave * 32 + r] = oacc[it][g];
  __syncthreads();
  {
    int ii = tid >> 2, seg = tid & 3;
    float v[32]; float ss = 0.f;
#pragma unroll
    for (int c = 0; c < 32; ++c) { v[c] = sO[ii * 129 + seg * 32 + c]; ss += v[c] * v[c]; }
    ss += __shfl_xor(ss, 1); ss += __shfl_xor(ss, 2);
    float rstd = rsqrtf(ss * (1.f / 128.f) + EPS);
    const float* gn = P.in[I_BON] + i * 128 + seg * 32;
    const u16* br = (const u16*)(P.ws + W_BR) + (size_t)(t0 + ii) * 512 + hd * 128 + seg * 32;
    u16* o = (u16*)(P.ws + W_OMIX) + (size_t)(t0 + ii) * 1024 + 512 + hd * 128 + seg * 32;
#pragma unroll
    for (int q = 0; q < 4; ++q) {
      u32x4 bu = *(const u32x4*)(br + q * 8);
      unsigned bw[4] = {bu.x, bu.y, bu.z, bu.w};
      unsigned ow[4];
#pragma unroll
      for (int e = 0; e < 4; ++e) {
        int c = q * 8 + e * 2;
        float o0 = v[c] * rstd * gn[c] * silu_f(bflo(bw[e]));
        float o1 = v[c + 1] * rstd * gn[c + 1] * silu_f(bfhi(bw[e]));
        ow[e] = pk2(o0, o1);
      }
      u32x4 ou = {ow[0], ow[1], ow[2], ow[3]};
      *(u32x4*)(o + q * 8) = ou;
    }
  }
  __syncthreads();
}

DI unsigned f2key(float f) { unsigned b = __float_as_uint(f); return b ^ ((unsigned)((int)b >> 31) | 0x80000000u); }
DI float key2f(unsigned k) { unsigned b = (k & 0x80000000u) ? (k ^ 0x80000000u) : ~k; return __uint_as_float(b); }
DI void ce_desc(unsigned& x, unsigned& y) { unsigned mx = max(x, y), mn = min(x, y); x = mx; y = mn; }
template <int B, int N>
DI void sort16_desc(unsigned (&a)[N]) {
#pragma unroll
  for (int k = 2; k <= 16; k <<= 1)
#pragma unroll
    for (int j = k >> 1; j > 0; j >>= 1)
#pragma unroll
      for (int i = 0; i < 16; ++i) {
        const int l = i ^ j;
        if (l > i) {
          if ((i & k) == 0) ce_desc(a[B + i], a[B + l]); else ce_desc(a[B + l], a[B + i]);
        }
      }
}
template <int A, int Bo, int N>
DI void merge16_desc(unsigned (&a)[N]) {
#pragma unroll
  for (int i = 0; i < 16; ++i) a[A + i] = max(a[A + i], a[Bo + 15 - i]);
#pragma unroll
  for (int j = 8; j > 0; j >>= 1)
#pragma unroll
    for (int i = 0; i < 16; ++i) {
      const int l = i ^ j;
      if (l > i) ce_desc(a[A + i], a[A + l]);
    }
}
DI void top16_of_64(unsigned (&a)[64]) {
  sort16_desc<0>(a); sort16_desc<16>(a); sort16_desc<32>(a); sort16_desc<48>(a);
  merge16_desc<0, 16>(a); merge16_desc<32, 48>(a); merge16_desc<0, 32>(a);
}

DI void peer_topk_phase(const Params& P, int l, char* smem) {
  const int tid = threadIdx.x, lane = tid & 63, wave = tid >> 6, r = lane & 31, h = lane >> 5;
  const u16* Q = (const u16*)(P.ws + W_Q);
  const u16* SK = (const u16*)(P.ws + W_SK) + (size_t)l * 8 * 2 * 128 * 64;
  for (int wi = blockIdx.x * 4 + wave; wi < (NTOK / 32) * 8; wi += gridDim.x * 4) {
    const int hd = wi & 7, t0 = (wi >> 3) * 32;
    unsigned lst[2][16];
    f32x16 accp[2][4];
    {
      bf16x8 bq[2][4], ak[2][4][4];
#pragma unroll
      for (int p = 0; p < 2; ++p)
#pragma unroll
        for (int ks = 0; ks < 4; ++ks) {
          bq[p][ks] = ld8(Q + (size_t)(t0 + r) * 1024 + hd * 128 + p * 64 + ks * 16 + h * 8);
#pragma unroll
          for (int kt = 0; kt < 4; ++kt) ak[p][ks][kt] = ld8(SK + ((size_t)(hd * 2 + p) * 128 + kt * 32 + r) * 64 + ks * 16 + h * 8);
        }
#pragma unroll
      for (int p = 0; p < 2; ++p) {
#pragma unroll
        for (int kt = 0; kt < 4; ++kt)
#pragma unroll
          for (int g = 0; g < 16; ++g) accp[p][kt][g] = 0.f;
#pragma unroll
        for (int ks = 0; ks < 4; ++ks)
#pragma unroll
          for (int kt = 0; kt < 4; ++kt) accp[p][kt] = MFMA(ak[p][ks][kt], bq[p][ks], accp[p][kt]);
      }
    }
#pragma unroll
    for (int p = 0; p < 2; ++p) {
      f32x16 (&acc)[4] = accp[p];
      unsigned a[64];
#pragma unroll
      for (int kt = 0; kt < 4; ++kt)
#pragma unroll
        for (int g = 0; g < 16; ++g) {
          const int key = kt * 32 + crow(g, h);
          a[kt * 16 + g] = (f2key(acc[kt][g]) & ~127u) | (unsigned)(127 - key);
        }
      top16_of_64(a);
#pragma unroll
      for (int i = 0; i < 16; ++i) a[16 + i] = (unsigned)__shfl_xor((int)a[i], 32);
      merge16_desc<0, 16>(a);
#pragma unroll
      for (int i = 0; i < 16; ++i) lst[p][i] = a[i];
    }
    unsigned c[64];
    {
      float v0[16], v1[16];
#pragma unroll
      for (int k = 0; k < 16; ++k) { v0[k] = key2f(lst[0][k] & ~127u); v1[k] = key2f(lst[1][k] & ~127u); }
      int n = 0;
#pragma unroll
      for (int a = 0; a < 16; ++a)
#pragma unroll
        for (int b = 0; b < 16; ++b)
          if ((a + 1) * (b + 1) <= 16) {
            const unsigned i0 = 127u - (lst[0][a] & 127u), i1 = 127u - (lst[1][b] & 127u);
            c[n] = (f2key(v0[a] + v1[b]) & 0xFFFFC000u) | (i0 << 7) | i1;
            ++n;
          }
#pragma unroll
      for (int k = 50; k < 64; ++k) c[k] = 0u;
    }
    top16_of_64(c);
    float fs[16];
    const float mx = key2f(c[0] & 0xFFFFC000u);
    float sum = 0.f;
#pragma unroll
    for (int k = 0; k < 16; ++k) { fs[k] = __expf(key2f(c[k] & 0xFFFFC000u) - mx); sum += fs[k]; }
    const float inv = 1.f / sum;
    const size_t ob = (size_t)(t0 + r) * 128 + hd * 16;
    if (h == 0) {
      int* eo = (int*)(P.ws + W_EIDX) + ob;
#pragma unroll
      for (int q = 0; q < 4; ++q) {
        u32x4 o = {c[q * 4] & 0x3FFFu, c[q * 4 + 1] & 0x3FFFu, c[q * 4 + 2] & 0x3FFFu, c[q * 4 + 3] & 0x3FFFu};
        *(u32x4*)(eo + q * 4) = o;
      }
    } else {
      float* go = (float*)(P.ws + W_EGATE) + ob;
#pragma unroll
      for (int q = 0; q < 4; ++q) {
        f32x4 o = {fs[q * 4] * inv, fs[q * 4 + 1] * inv, fs[q * 4 + 2] * inv, fs[q * 4 + 3] * inv};
        *(f32x4*)(go + q * 4) = o;
      }
    }
  }
}

DI float dpp_add(float e, float v, int) { return e + v; }
#define DPP_ADD(e, ctrl) ((e) + __int_as_float(__builtin_amdgcn_update_dpp(0, __float_as_int(e), (ctrl), 0xf, 0xf, true)))
DI float reduce4(float d0, float d1, float d2, float d3, int lane) {
  auto r01 = __builtin_amdgcn_permlane32_swap(__float_as_uint(d0), __float_as_uint(d1), false, false);
  const float a = __uint_as_float(r01[0]) + __uint_as_float(r01[1]);
  auto r23 = __builtin_amdgcn_permlane32_swap(__float_as_uint(d2), __float_as_uint(d3), false, false);
  const float c = __uint_as_float(r23[0]) + __uint_as_float(r23[1]);
  auto rq = __builtin_amdgcn_permlane16_swap(__float_as_uint(a), __float_as_uint(c), false, false);
  float e = __uint_as_float(rq[0]) + __uint_as_float(rq[1]);
  e = DPP_ADD(e, 0xB1);
  e = DPP_ADD(e, 0x4E);
  e = DPP_ADD(e, 0x141);
  e = DPP_ADD(e, 0x140);
  return e;
}
DI float dot16_fp8(const u32x4& w, const f32x2_t (&h2)[8]) {
  f32x2_t acc0 = {0.f, 0.f}, acc1 = {0.f, 0.f};
  acc0 = __builtin_amdgcn_cvt_pk_f32_fp8((int)w.x, false) * h2[0] + acc0;
  acc1 = __builtin_amdgcn_cvt_pk_f32_fp8((int)w.x, true) * h2[1] + acc1;
  acc0 = __builtin_amdgcn_cvt_pk_f32_fp8((int)w.y, false) * h2[2] + acc0;
  acc1 = __builtin_amdgcn_cvt_pk_f32_fp8((int)w.y, true) * h2[3] + acc1;
  acc0 = __builtin_amdgcn_cvt_pk_f32_fp8((int)w.z, false) * h2[4] + acc0;
  acc1 = __builtin_amdgcn_cvt_pk_f32_fp8((int)w.z, true) * h2[5] + acc1;
  acc0 = __builtin_amdgcn_cvt_pk_f32_fp8((int)w.w, false) * h2[6] + acc0;
  acc1 = __builtin_amdgcn_cvt_pk_f32_fp8((int)w.w, true) * h2[7] + acc1;
  acc0 += acc1;
  return acc0.x + acc0.y;
}
DI void axpy16_fp8(const u32x4& w, float s, f32x2_t (&y2)[8]) {
  const f32x2_t s2 = {s, s};
  y2[0] = __builtin_amdgcn_cvt_pk_f32_fp8((int)w.x, false) * s2 + y2[0];
  y2[1] = __builtin_amdgcn_cvt_pk_f32_fp8((int)w.x, true) * s2 + y2[1];
  y2[2] = __builtin_amdgcn_cvt_pk_f32_fp8((int)w.y, false) * s2 + y2[2];
  y2[3] = __builtin_amdgcn_cvt_pk_f32_fp8((int)w.y, true) * s2 + y2[3];
  y2[4] = __builtin_amdgcn_cvt_pk_f32_fp8((int)w.z, false) * s2 + y2[4];
  y2[5] = __builtin_amdgcn_cvt_pk_f32_fp8((int)w.z, true) * s2 + y2[5];
  y2[6] = __builtin_amdgcn_cvt_pk_f32_fp8((int)w.w, false) * s2 + y2[6];
  y2[7] = __builtin_amdgcn_cvt_pk_f32_fp8((int)w.w, true) * s2 + y2[7];
}

DI void axpy16_fp4(const u32x2& w, float s, f32x2_t (&y2)[8]) {
  const f32x2_t s2 = {s, s};
  y2[0] = __builtin_amdgcn_cvt_scalef32_pk_f32_fp4(w.x, 1.0f, 0) * s2 + y2[0];
  y2[1] = __builtin_amdgcn_cvt_scalef32_pk_f32_fp4(w.x, 1.0f, 1) * s2 + y2[1];
  y2[2] = __builtin_amdgcn_cvt_scalef32_pk_f32_fp4(w.x, 1.0f, 2) * s2 + y2[2];
  y2[3] = __builtin_amdgcn_cvt_scalef32_pk_f32_fp4(w.x, 1.0f, 3) * s2 + y2[3];
  y2[4] = __builtin_amdgcn_cvt_scalef32_pk_f32_fp4(w.y, 1.0f, 0) * s2 + y2[4];
  y2[5] = __builtin_amdgcn_cvt_scalef32_pk_f32_fp4(w.y, 1.0f, 1) * s2 + y2[5];
  y2[6] = __builtin_amdgcn_cvt_scalef32_pk_f32_fp4(w.y, 1.0f, 2) * s2 + y2[6];
  y2[7] = __builtin_amdgcn_cvt_scalef32_pk_f32_fp4(w.y, 1.0f, 3) * s2 + y2[7];
}
DI void peer_expert_phase(const Params& P, int l) {
  const int lane = threadIdx.x & 63, wave = threadIdx.x >> 6;
  const char* U = P.ws + W_PU + (size_t)l * 16384 * 1536 + lane * 16;
  const char* V = P.ws + W_PU + (size_t)l * 16384 * 1536 + 1024 + lane * 8;
  const float* SU = (const float*)(P.ws + W_PSU) + l * 16384;
  const float* SV = (const float*)(P.ws + W_PSV) + l * 16384;
  float* x = P.out + O_X;
  const int grp = lane >> 4;
  for (int t = blockIdx.x * 4 + wave; t < NTOK; t += gridDim.x * 4) {
    int isdec, b, s, mi; tokinfo(t, isdec, b, s, mi);
    const u16* hrow = (const u16*)(P.ws + W_H) + (size_t)t * 1024 + lane * 16;
    u32x4 hA = *(const u32x4*)hrow, hB = *(const u32x4*)(hrow + 8);
    f32x2_t h2[8] = {{bflo(hA.x), bfhi(hA.x)}, {bflo(hA.y), bfhi(hA.y)}, {bflo(hA.z), bfhi(hA.z)}, {bflo(hA.w), bfhi(hA.w)},
                     {bflo(hB.x), bfhi(hB.x)}, {bflo(hB.y), bfhi(hB.y)}, {bflo(hB.z), bfhi(hB.z)}, {bflo(hB.w), bfhi(hB.w)}};
    const int* ei = (const int*)(P.ws + W_EIDX) + (size_t)t * 128;
    const float* eg = (const float*)(P.ws + W_EGATE) + (size_t)t * 128;
    const int myi0 = ei[lane], myi1 = ei[64 + lane];
    const float mysu0 = SU[myi0], mysu1 = SU[myi1];
    const float myg0 = eg[lane] * SV[myi0], myg1 = eg[64 + lane] * SV[myi1];
    f32x2_t y2[8];
#pragma unroll
    for (int j = 0; j < 8; ++j) { y2[j].x = 0.f; y2[j].y = 0.f; }
    u32x4 un[16]; u32x2 vn[16];
#pragma unroll
    for (int u = 0; u < 16; ++u) {
      const int id = __builtin_amdgcn_readlane(myi0, u);
      un[u] = *(const u32x4*)(U + (size_t)id * 1536);
      vn[u] = *(const u32x2*)(V + (size_t)id * 1536);
    }
    for (int e0 = 0; e0 < 128; e0 += 16) {
      u32x4 uc[16]; u32x2 vc[16];
#pragma unroll
      for (int u = 0; u < 16; ++u) { uc[u] = un[u]; vc[u] = vn[u]; }
      if (e0 + 16 < 128) {
        const int e1 = e0 + 16;
        const int srci = (e1 < 64) ? myi0 : myi1;
#pragma unroll
        for (int u = 0; u < 16; ++u) {
          const int id = __builtin_amdgcn_readlane(srci, (e1 + u) & 63);
          un[u] = *(const u32x4*)(U + (size_t)id * 1536);
          vn[u] = *(const u32x2*)(V + (size_t)id * 1536);
        }
      }
      const float gsrc = (e0 < 64) ? myg0 : myg1;
      const float ssrc = (e0 < 64) ? mysu0 : mysu1;
#pragma unroll
      for (int hb = 0; hb < 4; ++hb) {
        float su[4], gt[4];
#pragma unroll
        for (int u = 0; u < 4; ++u) {
          su[u] = __int_as_float(__builtin_amdgcn_readlane(__float_as_int(ssrc), (e0 + hb * 4 + u) & 63));
          gt[u] = __int_as_float(__builtin_amdgcn_readlane(__float_as_int(gsrc), (e0 + hb * 4 + u) & 63));
        }
        float d0 = dot16_fp8(uc[hb * 4 + 0], h2), d1 = dot16_fp8(uc[hb * 4 + 1], h2), d2 = dot16_fp8(uc[hb * 4 + 2], h2), d3 = dot16_fp8(uc[hb * 4 + 3], h2);
        float e = reduce4(d0, d1, d2, d3, lane);
        const float su_s = (grp == 0) ? su[0] : (grp == 1) ? su[2] : (grp == 2) ? su[1] : su[3];
        const float w_s = (grp == 0) ? gt[0] : (grp == 1) ? gt[2] : (grp == 2) ? gt[1] : gt[3];
        const float pre = e * su_s;
        const float act = 0.5f * pre * (1.f + erff(pre * 0.70710678118654752f));
        const float w = act * w_s;
        const float w0 = __int_as_float(__builtin_amdgcn_readlane(__float_as_int(w), 0));
        const float w1 = __int_as_float(__builtin_amdgcn_readlane(__float_as_int(w), 32));
        const float w2 = __int_as_float(__builtin_amdgcn_readlane(__float_as_int(w), 16));
        const float w3 = __int_as_float(__builtin_amdgcn_readlane(__float_as_int(w), 48));
        axpy16_fp4(vc[hb * 4 + 0], w0, y2); axpy16_fp4(vc[hb * 4 + 1], w1, y2); axpy16_fp4(vc[hb * 4 + 2], w2, y2); axpy16_fp4(vc[hb * 4 + 3], w3, y2);
      }
    }
    const float* g2 = (const float*)(P.ws + W_MOD) + ((size_t)l * 5 + mi) * 6144 + 5 * 1024 + lane * 16;
    float* xr = x + (size_t)t * 1024 + lane * 16;
    float xn[16];
#pragma unroll
    for (int q = 0; q < 4; ++q) {
      f32x4 xv = *(const f32x4*)(xr + q * 4), gv = *(const f32x4*)(g2 + q * 4);
      xv.x += gv.x * y2[q * 2].x; xv.y += gv.y * y2[q * 2].y; xv.z += gv.z * y2[q * 2 + 1].x; xv.w += gv.w * y2[q * 2 + 1].y;
      *(f32x4*)(xr + q * 4) = xv;
      xn[q * 4] = xv.x; xn[q * 4 + 1] = xv.y; xn[q * 4 + 2] = xv.z; xn[q * 4 + 3] = xv.w;
    }
    if (l < 3) {
      float ss = 0.f;
#pragma unroll
      for (int j = 0; j < 16; ++j) ss += xn[j] * xn[j];
      ss = wave_sum(ss);
      float rstd = rsqrtf(ss * (1.f / 1024.f) + EPS);
      const float* g = P.in[I_NMG] + (l + 1) * 1024 + lane * 16;
      const float* mod = (const float*)(P.ws + W_MOD) + ((size_t)(l + 1) * 5 + mi) * 6144 + lane * 16;
      u16* hh = (u16*)(P.ws + W_H) + (size_t)t * 1024 + lane * 16;
#pragma unroll
      for (int hf = 0; hf < 2; ++hf) {
        float o[8];
#pragma unroll
        for (int q = 0; q < 8; ++q) o[q] = xn[hf * 8 + q] * rstd * g[hf * 8 + q] * (1.f + mod[1024 + hf * 8 + q]) + mod[hf * 8 + q];
        u32x4 ou = {pk2(o[0], o[1]), pk2(o[2], o[3]), pk2(o[4], o[5]), pk2(o[6], o[7])};
        *(u32x4*)(hh + hf * 8) = ou;
      }
    }
  }
}

DI void mixer1_phase(const Params& P, int i, char* smem) {
  const int xcd = blockIdx.x & 7, nloc = gridDim.x >> 3;
  for (int q = blockIdx.x >> 3; q < 96; q += nloc) {
    int item;
    if (q < 64) { const int b = xcd >> 1, head = (xcd & 1) * 4 + (q >> 4), n = q & 15; item = b * 128 + head * 16 + n; }
    else { const int it = q - 64, b = xcd + 8 * (it >> 3), head = it & 7; item = 512 + b * 8 + head; }
    attnA_item(P, i, item, smem);
  }
  for (int item = blockIdx.x; item < 1536; item += gridDim.x) gla_b1_item(P, i, item, smem);
}

#define XB_TMO      128
#define XB_XCNT(j)  (256  + 64 * (j))
#define XB_XSUB(j)  (1280 + 64 * (j))
#define XB_XGEN(j)  (2304 + 64 * (j))
#define XB_TOP      3328
#define XB_TOPGEN   3392
#define XCD_BAR_WORDS 3456
#define XB_SPIN_CAP (1u << 20)
#define LAS __attribute__((address_space(3)))
DI unsigned xb_ld(unsigned* p)              { return __hip_atomic_load(p, __ATOMIC_RELAXED, __HIP_MEMORY_SCOPE_AGENT); }
DI unsigned xb_add(unsigned* p, unsigned v) { return __hip_atomic_fetch_add(p, v, __ATOMIC_RELAXED, __HIP_MEMORY_SCOPE_AGENT); }
DI unsigned xb_xcc_id() { return (unsigned)__builtin_amdgcn_s_getreg((3 << 11) | 20) & 0xFu; }
#define XB_SPIN(cond, bar) do { unsigned _sp = 0; while (cond) { __builtin_amdgcn_s_sleep(1); \
    if ((++_sp & 255u) == 0u) { if (xb_ld(&(bar)[XB_TMO])) break; if (_sp > XB_SPIN_CAP) { atomicAdd(&(bar)[XB_TMO], 1u); break; } } } } while (0)
struct XcdBarrier { unsigned* bar; unsigned x; volatile LAS unsigned* st; };
DI XcdBarrier xcd_barrier_post(unsigned* bar, volatile LAS unsigned* st) {
  XcdBarrier b; b.bar = bar; b.x = xb_xcc_id(); b.st = st;
  if (threadIdx.x == 0) (void)xb_add(&bar[XB_XCNT(b.x)], 1u);
  return b;
}
DI XcdBarrier make_xb(const Params& P, char* smem) {
  XcdBarrier b; b.bar = (unsigned*)(P.ws + W_BAR); b.x = xb_xcc_id(); b.st = (volatile LAS unsigned*)(smem + SMEM_BYTES - 16);
  return b;
}
DI void xcd_barrier_complete(unsigned* bar, unsigned x, unsigned& nloc, unsigned& nx) {
  const unsigned G = gridDim.x * gridDim.y * gridDim.z;
  unsigned sum, cnt, mine, sp = 0u;
  for (;;) {
    sum = 0u; cnt = 0u; mine = 0u;
#pragma unroll
    for (unsigned j = 0; j < 16; ++j) { const unsigned c = xb_ld(&bar[XB_XCNT(j)]); sum += c; cnt += (c > 0u) ? 1u : 0u; mine = (j == x) ? c : mine; }
    if (sum == G) break;
    __builtin_amdgcn_s_sleep(1);
    if ((++sp & 255u) == 0u) { if (xb_ld(&bar[XB_TMO])) break; if (sp > XB_SPIN_CAP) { atomicAdd(&bar[XB_TMO], 1u); break; } }
  }
  nloc = mine > 0u ? mine : 1u; nx = cnt > 0u ? cnt : 1u;
}
DI void xcd_barrier(const XcdBarrier& b) {
  asm volatile("s_waitcnt vmcnt(0)" ::: "memory");
  __syncthreads();
  if (threadIdx.x == 0) {
    unsigned* bar = b.bar;
    __builtin_amdgcn_s_waitcnt(0);
    unsigned nloc = b.st[0], nx = b.st[1];
    if (nloc == 0u) { xcd_barrier_complete(bar, b.x, nloc, nx); b.st[0] = nloc; b.st[1] = nx; }
    const unsigned old = xb_add(&bar[XB_XSUB(b.x)], 1u);
    const unsigned gen = old / nloc;
    if (old + 1u == (gen + 1u) * nloc) {
      __builtin_amdgcn_fence(__ATOMIC_RELEASE, "agent");
      asm volatile("s_waitcnt vmcnt(0)" ::: "memory");
      const unsigned og = xb_add(&bar[XB_TOP], 1u);
      const unsigned tg = og / nx;
      if (og + 1u == (tg + 1u) * nx) xb_add(&bar[XB_TOPGEN], 1u);
      else XB_SPIN(xb_ld(&bar[XB_TOPGEN]) == tg, bar);
      __builtin_amdgcn_fence(__ATOMIC_ACQUIRE, "agent");
      xb_add(&bar[XB_XGEN(b.x)], 1u);
      asm volatile("s_waitcnt vmcnt(0)" ::: "memory");
    } else {
      XB_SPIN(xb_ld(&bar[XB_XGEN(b.x)]) == gen, bar);
      __builtin_amdgcn_fence(__ATOMIC_ACQUIRE, "agent");
      asm volatile("s_waitcnt vmcnt(0)" ::: "memory");
    }
  }
  __syncthreads();
}

#ifndef REP0
#define REP0 1
#define REP1 1
#define REP2 1
#define REP3 1
#define REP4 1
#define REP5 1
#define REP6 1
#endif
#define PHASE(body) { body; xcd_barrier(make_xb(P, smem)); }
#define PHASE_R(c, body) for (int r_ = 0; r_ < P.rep[c]; ++r_) { body; xcd_barrier(make_xb(P, smem)); }
template <int L>
DI void run_layer(const Params& P, char* smem) {
  constexpr int l = L, i = L >> 1;
  if ((l & 1) == 0) {
    PHASE_R(2, gemm_phase((const u16*)(P.ws + W_H), (const u16*)(P.ws + W_EIN) + (size_t)i * EIN_PAD * 1024, 19, EpiEvenIn{&P, i}, smem));
    PHASE_R(3, mixer1_phase(P, i, smem));
    PHASE(gla_scan_phase(P, i));
    PHASE_R(3, { for (int item = blockIdx.x; item < 1536; item += gridDim.x) gla_b3_item(P, i, item, smem); });
    PHASE(gemm_phase((const u16*)(P.ws + W_OMIX), (const u16*)(P.ws + W_EOUT) + (size_t)i * 1024 * 1024, 8, EpiOut{&P, l}, smem));
  } else {
    PHASE_R(2, gemm_phase((const u16*)(P.ws + W_H), (const u16*)(P.ws + W_OIN) + (size_t)i * 3072 * 1024, 24, EpiOddIn{&P, i}, smem));
    PHASE_R(4, attnC_phase(P, i, smem));
    PHASE(gemm_phase((const u16*)(P.ws + W_OMIX), (const u16*)(P.ws + W_OOUT) + (size_t)i * 1024 * 1024, 8, EpiOut{&P, l}, smem));
  }
  PHASE_R(1, modnorm_phase(P, l, 1));
  PHASE_R(5, gemm_phase((const u16*)(P.ws + W_H), (const u16*)(P.ws + W_PQ) + (size_t)l * 1024 * 1024, 8, EpiPQ{&P}, smem));
  PHASE_R(6, peer_topk_phase(P, l, smem));
  if (l < 3) { PHASE(peer_expert_phase(P, l)); } else { peer_expert_phase(P, l); }
}

__global__ void __launch_bounds__(256) trunk_megakernel(Params P) {
  cg::grid_group grid = cg::this_grid();
  __shared__ __attribute__((aligned(16))) char smem[SMEM_BYTES];
  if (threadIdx.x == 0) { u32x4 z = {0u, 0u, 0u, 0u}; *(u32x4*)(smem + SMEM_BYTES - 16) = z; }
  __syncthreads();
  (void)xcd_barrier_post((unsigned*)(P.ws + W_BAR), (volatile LAS unsigned*)(smem + SMEM_BYTES - 16));
  prep_phase(P, smem);
  xcd_barrier(make_xb(P, smem));
  if (P.rep[7] == 0x7fffffff) grid.sync();
  PHASE_R(1, modnorm_phase(P, 0, 0));
  run_layer<0>(P, smem);
  run_layer<1>(P, smem);
  run_layer<2>(P, smem);
  run_layer<3>(P, smem);
}
#undef PHASE
#undef PHASE_R

extern "C" void kernel_launch(void* const* d_in, const int* in_sizes, int n_in, void* d_out, int out_size, void* d_ws, size_t ws_size,
                              hipStream_t stream) {
  static int grid_blocks = 0;
  if (!grid_blocks) {
    int dev = 0, cus = 0, per_cu = 0;
    hipGetDevice(&dev);
    hipDeviceGetAttribute(&cus, hipDeviceAttributeMultiprocessorCount, dev);
    hipOccupancyMaxActiveBlocksPerMultiprocessor(&per_cu, trunk_megakernel, 256, 0);
    if (per_cu > 2) per_cu = 2;
    if (per_cu < 1) per_cu = 1;
    grid_blocks = (cus * per_cu) & ~7;
    if (grid_blocks < 8) grid_blocks = 8;
  }
  Params p{};
  for (int k = 0; k < N_IN; ++k) p.in[k] = (const float*)d_in[k];
  p.out = (float*)d_out;
  p.ws = (char*)d_ws;
  p.lam_init[0] = (float)(0.8 - 0.6 * std::exp(-0.3 * 1.0));
  p.lam_init[1] = (float)(0.8 - 0.6 * std::exp(-0.3 * 3.0));
  p.rep[0] = REP0; p.rep[1] = REP1; p.rep[2] = REP2; p.rep[3] = REP3; p.rep[4] = REP4; p.rep[5] = REP5; p.rep[6] = REP6; p.rep[7] = 1;
  hipMemsetAsync((char*)d_ws + W_BAR, 0, XCD_BAR_WORDS * sizeof(unsigned), stream);
  void* args[] = {&p};
  hipError_t e = hipLaunchCooperativeKernel((void*)trunk_megakernel, dim3(grid_blocks), dim3(256), args, 0, stream);
  if (e != hipSuccess) fprintf(stderr, "cooperative launch failed: %s (grid %d)\n", hipGetErrorString(e), grid_blocks);
}
```

```cpp
#include <hip/hip_runtime.h>
#include <hip/hip_cooperative_groups.h>
#include <cmath>
#include <cstdio>
namespace cg = cooperative_groups;

typedef unsigned short u16;
typedef short bf16x8 __attribute__((ext_vector_type(8)));
typedef float f32x16 __attribute__((ext_vector_type(16)));
typedef __bf16 bf16x2_t __attribute__((ext_vector_type(2)));
typedef float f32x2_t __attribute__((ext_vector_type(2)));
typedef unsigned u32x4 __attribute__((ext_vector_type(4)));
typedef unsigned u32x2 __attribute__((ext_vector_type(2)));
typedef float f32x4 __attribute__((ext_vector_type(4)));
#define DI __device__ __forceinline__
#define MFMA(a, b, c) __builtin_amdgcn_mfma_f32_32x32x16_bf16((a), (b), (c), 0, 0, 0)

constexpr int D = 1024;
constexpr int NTOK = 24576;
constexpr int NCTX = 8192;
constexpr int EIN_PAD = 2432;
constexpr float LOG2E = 1.4426950408889634f;
constexpr float QSCALE = 0.125f * LOG2E;
constexpr float EPS = 1e-6f;

enum { I_XP = 0, I_XS, I_CAK, I_CAV, I_SBF, I_SBB, I_CCK, I_CCV, I_C, I_CCTX, I_ADAW, I_ADAB, I_NMG, I_NFG, I_EWIN, I_EWOUT,
       I_AQN, I_AKN, I_ASINK, I_GWF, I_GBF, I_GWB, I_GBB, I_BON, I_OWIN, I_OWOUT, I_CQN, I_CKN, I_LQ1, I_LK1, I_LQ2, I_LK2, I_CON,
       I_PWQ, I_PSK, I_PU, I_PV, N_IN };

constexpr size_t O_X = 0;
constexpr size_t O_CAK = 25165824;
constexpr size_t O_CAV = 27262976;
constexpr size_t O_SBF = 29360128;
constexpr size_t O_SBB = 31457280;
constexpr size_t O_CCK = 33554432;
constexpr size_t O_CCV = 50331648;

constexpr size_t W_EIN = 0;
constexpr size_t W_OIN = W_EIN + 2ull * EIN_PAD * 1024 * 2;
constexpr size_t W_EOUT = W_OIN + 2ull * 3072 * 1024 * 2;
constexpr size_t W_OOUT = W_EOUT + 2ull * 1024 * 1024 * 2;
constexpr size_t W_PQ = W_OOUT + 2ull * 1024 * 1024 * 2;
constexpr size_t W_SK = W_PQ + 4ull * 1024 * 1024 * 2;
constexpr size_t W_PU = W_SK + 4ull * 8 * 2 * 128 * 64 * 2;
constexpr size_t W_PV = W_PU + 4ull * 16384 * 1024 * 2;
constexpr size_t W_MOD = W_PV + 4ull * 16384 * 1024 * 2;
constexpr size_t W_ROPE = W_MOD + 4ull * 5 * 6144 * 4;
constexpr size_t W_LAM = W_ROPE + 64 * 16 * 2 * 4;
constexpr size_t W_H = W_LAM + 256;
constexpr size_t W_Q = W_H + (size_t)NTOK * 1024 * 2;
constexpr size_t W_OMIX = W_Q + (size_t)NTOK * 1024 * 2;
constexpr size_t SZ_KA_DEC = 4ull * 2 * 4608 * 64 * 2;
constexpr size_t W_KA_DEC = W_OMIX + (size_t)NTOK * 1024 * 2;
constexpr size_t W_VAT_DEC = W_KA_DEC + 2 * SZ_KA_DEC;
constexpr size_t W_KA_CTX = W_VAT_DEC + 2 * SZ_KA_DEC;
constexpr size_t W_VAT_CTX = W_KA_CTX + 32ull * 2 * 256 * 64 * 2;
constexpr size_t SZ_KC_DEC = 4ull * 8 * 2 * 4608 * 64 * 2;
constexpr size_t W_KC_DEC = W_VAT_CTX + 32ull * 2 * 256 * 64 * 2;
constexpr size_t W_VCT_DEC = W_KC_DEC + 2 * SZ_KC_DEC;
constexpr size_t W_KC_CTX = W_VCT_DEC + 2 * SZ_KC_DEC;
constexpr size_t W_VCT_CTX = W_KC_CTX + 32ull * 8 * 2 * 256 * 64 * 2;
constexpr size_t W_BQ = W_VCT_CTX + 32ull * 8 * 128 * 256 * 2;
constexpr size_t W_BK = W_BQ + (size_t)NTOK * 256 * 2;
constexpr size_t W_BV = W_BK + (size_t)NTOK * 256 * 2;
constexpr size_t W_BR = W_BV + (size_t)NTOK * 512 * 2;
constexpr size_t W_BG = W_BR + (size_t)NTOK * 512 * 2;
constexpr size_t W_KV = W_BG + (size_t)NTOK * 32 * 4;
constexpr size_t W_DEC = W_KV + 1536ull * 2 * 8192 * 4;
constexpr size_t W_EIDX = W_DEC + 1536ull * 2 * 64 * 4;
constexpr size_t W_EGATE = W_EIDX + (size_t)NTOK * 128 * 4;
constexpr size_t W_PSU = W_EGATE + (size_t)NTOK * 128 * 4;
constexpr size_t W_PSV = W_PSU + 4ull * 16384 * 4;
constexpr size_t W_END = W_PSV + 4ull * 16384 * 4;
constexpr size_t W_BAR = W_END;
static_assert(W_BAR + 16384 < (1ull << 30), "workspace budget");

struct Params {
  const float* in[N_IN];
  float* out;
  char* ws;
  float lam_init[2];
  int rep[8];
};

constexpr int SMEM_BYTES = 256 * 129 * 4 + 512;

DI unsigned pk2(float a, float b) {
  f32x2_t v = {a, b};
  bf16x2_t r = __builtin_convertvector(v, bf16x2_t);
  return __builtin_bit_cast(unsigned, r);
}
DI u16 f2bf(float a) { return (u16)(pk2(a, 0.f) & 0xffffu); }
DI float bf2f(u16 v) { return __uint_as_float(((unsigned)v) << 16); }
DI float bflo(unsigned w) { return __uint_as_float(w << 16); }
DI float bfhi(unsigned w) { return __uint_as_float(w & 0xffff0000u); }
DI int crow(int g, int h) { return (g & 3) + 8 * (g >> 2) + 4 * h; }
DI int pi32(int r) { return (r & ~12) | ((r & 4) << 1) | ((r & 8) >> 1); }
DI bf16x8 ld8(const u16* p) { return __builtin_bit_cast(bf16x8, *(const u32x4*)p); }
DI float wave_sum(float v) {
#pragma unroll
  for (int o = 32; o >= 1; o >>= 1) v += __shfl_xor(v, o);
  return v;
}
DI float silu_f(float x) { return x / (1.f + __expf(-x)); }
DI float dot2bf(unsigned a, unsigned b, float acc) {
  return __builtin_amdgcn_fdot2_f32_bf16(__builtin_bit_cast(bf16x2_t, a), __builtin_bit_cast(bf16x2_t, b), acc, false);
}
DI void tokinfo(int t, int& isdec, int& b, int& s, int& mi) {
  if (t < NCTX) { isdec = 0; b = t >> 8; s = t & 255; mi = 0; }
  else { int u = t - NCTX; isdec = 1; b = u >> 12; s = u & 4095; mi = 1 + b; }
}

DI void transpose_w(const float* __restrict__ src, u16* __restrict__ dst, int N, int Npad) {
  size_t total = (size_t)Npad * 128;
  for (size_t idx = (size_t)blockIdx.x * blockDim.x + threadIdx.x; idx < total; idx += (size_t)gridDim.x * blockDim.x) {
    int n = (int)(idx % Npad), kc = (int)(idx / Npad);
    float v[8];
#pragma unroll
    for (int j = 0; j < 8; ++j) v[j] = (n < N) ? src[(size_t)(kc * 8 + j) * N + n] : 0.f;
    u32x4 o = {pk2(v[0], v[1]), pk2(v[2], v[3]), pk2(v[4], v[5]), pk2(v[6], v[7])};
    *(u32x4*)(dst + (size_t)n * 1024 + kc * 8) = o;
  }
}
DI void convert_bf16(const float* __restrict__ src, u16* __restrict__ dst, size_t n) {
  size_t n8 = n >> 3;
  for (size_t idx = (size_t)blockIdx.x * blockDim.x + threadIdx.x; idx < n8; idx += (size_t)gridDim.x * blockDim.x) {
    f32x4 a = ((const f32x4*)src)[idx * 2], b = ((const f32x4*)src)[idx * 2 + 1];
    u32x4 o = {pk2(a.x, a.y), pk2(a.z, a.w), pk2(b.x, b.y), pk2(b.z, b.w)};
    ((u32x4*)dst)[idx] = o;
  }
}

DI void prep_phase(const Params& P, char* smem) {
  char* ws = P.ws;
  const int tid = threadIdx.x;
  const size_t gtid = (size_t)blockIdx.x * blockDim.x + tid, gsz = (size_t)gridDim.x * blockDim.x;
  {
    float* sS = (float*)smem;
    float* sR = sS + 5 * 1024;
    for (int idx = tid; idx < 5 * 1024; idx += 256) {
      int ci = idx >> 10, k = idx & 1023;
      float c = (ci == 0) ? P.in[I_CCTX][k] : P.in[I_C][(ci - 1) * 1024 + k];
      sS[idx] = silu_f(c);
    }
    __syncthreads();
    float* mod = (float*)(ws + W_MOD);
    for (int item = blockIdx.x; item < 4 * 96; item += gridDim.x) {
      int l = item / 96, ch = item % 96;
      int col = tid & 63, kq = tid >> 6;
      const float* w = P.in[I_ADAW] + (size_t)l * 1024 * 6144 + ch * 64 + col;
      float a0 = 0, a1 = 0, a2 = 0, a3 = 0, a4 = 0;
#pragma unroll 16
      for (int k = kq * 256; k < kq * 256 + 256; ++k) {
        float wv = w[(size_t)k * 6144];
        a0 += sS[k] * wv; a1 += sS[1024 + k] * wv; a2 += sS[2048 + k] * wv; a3 += sS[3072 + k] * wv; a4 += sS[4096 + k] * wv;
      }
      sR[(kq * 5 + 0) * 64 + col] = a0; sR[(kq * 5 + 1) * 64 + col] = a1; sR[(kq * 5 + 2) * 64 + col] = a2;
      sR[(kq * 5 + 3) * 64 + col] = a3; sR[(kq * 5 + 4) * 64 + col] = a4;
      __syncthreads();
      for (int idx = tid; idx < 320; idx += 256) {
        int ci = idx >> 6, c2 = idx & 63;
        float s = sR[(0 * 5 + ci) * 64 + c2] + sR[(1 * 5 + ci) * 64 + c2] + sR[(2 * 5 + ci) * 64 + c2] + sR[(3 * 5 + ci) * 64 + c2];
        mod[((size_t)l * 5 + ci) * 6144 + ch * 64 + c2] = s + P.in[I_ADAB][l * 6144 + ch * 64 + c2];
      }
      __syncthreads();
    }
  }
  for (int i = 0; i < 2; ++i) {
    transpose_w(P.in[I_EWIN] + (size_t)i * 1024 * 2336, (u16*)(ws + W_EIN) + (size_t)i * EIN_PAD * 1024, 2336, EIN_PAD);
    transpose_w(P.in[I_OWIN] + (size_t)i * 1024 * 3072, (u16*)(ws + W_OIN) + (size_t)i * 3072 * 1024, 3072, 3072);
    transpose_w(P.in[I_EWOUT] + (size_t)i * 1024 * 1024, (u16*)(ws + W_EOUT) + (size_t)i * 1024 * 1024, 1024, 1024);
    transpose_w(P.in[I_OWOUT] + (size_t)i * 1024 * 1024, (u16*)(ws + W_OOUT) + (size_t)i * 1024 * 1024, 1024, 1024);
  }
  for (int l = 0; l < 4; ++l)
    transpose_w(P.in[I_PWQ] + (size_t)l * 1024 * 1024, (u16*)(ws + W_PQ) + (size_t)l * 1024 * 1024, 1024, 1024);
  convert_bf16(P.in[I_PSK], (u16*)(ws + W_SK), 4ull * 8 * 2 * 128 * 64);
  {
    const int lane = tid & 63, wv = tid >> 6;
    for (int row0 = (blockIdx.x * 4 + wv) * 4; row0 < 2 * 65536; row0 += gridDim.x * 16) {
      const int which = row0 >> 16, rr0 = row0 & 65535;
      const float* srcp = P.in[which ? I_PV : I_PU] + (size_t)rr0 * 1024 + lane * 16;
      f32x4 a[4][4];
#pragma unroll
      for (int q = 0; q < 4; ++q)
#pragma unroll
        for (int j = 0; j < 4; ++j) a[q][j] = *(const f32x4*)(srcp + (size_t)q * 1024 + j * 4);
#pragma unroll
      for (int q = 0; q < 4; ++q) {
        float m = 0.f;
#pragma unroll
        for (int j = 0; j < 4; ++j) m = fmaxf(m, fmaxf(fmaxf(fabsf(a[q][j].x), fabsf(a[q][j].y)), fmaxf(fabsf(a[q][j].z), fabsf(a[q][j].w))));
#pragma unroll
        for (int o = 32; o >= 1; o >>= 1) m = fmaxf(m, __shfl_xor(m, o));
        const float sc = (m > 0.f) ? m * (1.f / 440.f) : 1.f;
        const float inv = 1.f / sc;
        if (which) {
          const float sc4 = (m > 0.f) ? m * (1.f / 6.f) : 1.f;
          const float inv4 = 1.f / sc4;
          unsigned w0 = 0, w1 = 0;
          w0 = __builtin_amdgcn_cvt_scalef32_pk_fp4_f32(w0, a[q][0].x * inv4, a[q][0].y * inv4, 1.0f, 0);
          w0 = __builtin_amdgcn_cvt_scalef32_pk_fp4_f32(w0, a[q][0].z * inv4, a[q][0].w * inv4, 1.0f, 1);
          w0 = __builtin_amdgcn_cvt_scalef32_pk_fp4_f32(w0, a[q][1].x * inv4, a[q][1].y * inv4, 1.0f, 2);
          w0 = __builtin_amdgcn_cvt_scalef32_pk_fp4_f32(w0, a[q][1].z * inv4, a[q][1].w * inv4, 1.0f, 3);
          w1 = __builtin_amdgcn_cvt_scalef32_pk_fp4_f32(w1, a[q][2].x * inv4, a[q][2].y * inv4, 1.0f, 0);
          w1 = __builtin_amdgcn_cvt_scalef32_pk_fp4_f32(w1, a[q][2].z * inv4, a[q][2].w * inv4, 1.0f, 1);
          w1 = __builtin_amdgcn_cvt_scalef32_pk_fp4_f32(w1, a[q][3].x * inv4, a[q][3].y * inv4, 1.0f, 2);
          w1 = __builtin_amdgcn_cvt_scalef32_pk_fp4_f32(w1, a[q][3].z * inv4, a[q][3].w * inv4, 1.0f, 3);
          u32x2 o = {w0, w1};
          *(u32x2*)(ws + W_PU + (size_t)(rr0 + q) * 1536 + 1024 + lane * 8) = o;
          if (lane == 0) ((float*)(ws + W_PSV))[rr0 + q] = sc4;
        } else {
          unsigned w[4];
#pragma unroll
          for (int j = 0; j < 4; ++j) {
            int t = __builtin_amdgcn_cvt_pk_fp8_f32(a[q][j].x * inv, a[q][j].y * inv, 0, false);
            t = __builtin_amdgcn_cvt_pk_fp8_f32(a[q][j].z * inv, a[q][j].w * inv, t, true);
            w[j] = (unsigned)t;
          }
          u32x4 o = {w[0], w[1], w[2], w[3]};
          *(u32x4*)(ws + W_PU + (size_t)(rr0 + q) * 1536 + lane * 16) = o;
          if (lane == 0) ((float*)(ws + W_PSU))[rr0 + q] = sc;
        }
      }
    }
  }
  {
    size_t n = 4ull * 2 * 512 * 2 * 64;
    for (size_t idx = gtid; idx < n; idx += gsz) {
      int d = idx & 63, kv = (idx >> 6) & 1, s = (idx >> 7) & 511, i = (idx >> 16) & 1, b = (int)(idx >> 17);
      float kvv = P.in[I_CAK][idx], vv = P.in[I_CAV][idx];
      u16* ka = (u16*)(ws + W_KA_DEC + i * SZ_KA_DEC);
      u16* va = (u16*)(ws + W_VAT_DEC + i * SZ_KA_DEC);
      ka[((size_t)(b * 2 + kv) * 4608 + 4096 + s) * 64 + d] = f2bf(kvv);
      va[((size_t)(b * 2 + kv) * 64 + d) * 4608 + 4096 + s] = f2bf(vv);
    }
    n = 4ull * 2 * 512 * 8 * 2 * 64;
    for (size_t idx = gtid; idx < n; idx += gsz) {
      int d = idx & 63, m = (idx >> 6) & 1, hd = (idx >> 7) & 7, s = (idx >> 10) & 511, i = (idx >> 19) & 1, b = (int)(idx >> 20);
      u16* kc = (u16*)(ws + W_KC_DEC + i * SZ_KC_DEC);
      kc[(((size_t)(b * 8 + hd) * 2 + m) * 4608 + 4096 + s) * 64 + d] = f2bf(P.in[I_CCK][idx]);
    }
    for (size_t idx = gtid; idx < n; idx += gsz) {
      int dv = idx & 127, hd = (idx >> 7) & 7, s = (idx >> 10) & 511, i = (idx >> 19) & 1, b = (int)(idx >> 20);
      u16* vc = (u16*)(ws + W_VCT_DEC + i * SZ_KC_DEC);
      vc[((size_t)(b * 8 + hd) * 128 + dv) * 4608 + 4096 + s] = f2bf(P.in[I_CCV][idx]);
    }
  }
  if (blockIdx.x == 0) {
    float* rt = (float*)(ws + W_ROPE);
    for (int idx = tid; idx < 64 * 16; idx += 256) {
      int p = idx >> 4, f = idx & 15;
      float freq = powf(10000.0f, -(float)f / 16.0f);
      float ang = (float)p * freq;
      rt[idx * 2] = cosf(ang); rt[idx * 2 + 1] = sinf(ang);
    }
    if (tid < 2) {
      float s1 = 0, s2 = 0;
      for (int k = 0; k < 64; ++k) {
        s1 += P.in[I_LQ1][tid * 64 + k] * P.in[I_LK1][tid * 64 + k];
        s2 += P.in[I_LQ2][tid * 64 + k] * P.in[I_LK2][tid * 64 + k];
      }
      ((float*)(ws + W_LAM))[tid] = expf(s1) - expf(s2) + P.lam_init[tid];
      float ga = 0, gk = 0, gc = 0, gck = 0;
      for (int k = 0; k < 64; ++k) {
        ga = fmaxf(ga, fabsf(P.in[I_AQN][tid * 64 + k])); gk = fmaxf(gk, fabsf(P.in[I_AKN][tid * 64 + k]));
        gc = fmaxf(gc, fabsf(P.in[I_CQN][tid * 64 + k])); gck = fmaxf(gck, fabsf(P.in[I_CKN][tid * 64 + k]));
      }
      float ma = 64.f * ga * gk * QSCALE * 1.03f + 0.01f;
      for (int k = 0; k < 8; ++k) ma = fmaxf(ma, P.in[I_ASINK][tid * 8 + k] * LOG2E);
      ((float*)(ws + W_LAM))[2 + tid] = ma;
      ((float*)(ws + W_LAM))[4 + tid] = 64.f * gc * gck * QSCALE * 1.03f + 0.01f;
    }
  }
}

DI void modnorm_row_write(const Params& P, int l, int which, int t, int lane, const float (&xv)[16]) {
  int isdec, b, s, mi; tokinfo(t, isdec, b, s, mi);
  float ss = 0;
#pragma unroll
  for (int j = 0; j < 16; ++j) ss += xv[j] * xv[j];
  ss = wave_sum(ss);
  float rstd = rsqrtf(ss * (1.f / 1024.f) + EPS);
  const float* g = P.in[which ? I_NFG : I_NMG] + l * 1024;
  const float* mod = (const float*)(P.ws + W_MOD) + ((size_t)l * 5 + mi) * 6144;
  const float* sc = mod + (which ? 4 : 1) * 1024;
  const float* sh = mod + (which ? 3 : 0) * 1024;
  u16* h = (u16*)(P.ws + W_H) + (size_t)t * 1024;
#pragma unroll
  for (int j = 0; j < 4; ++j) {
    int c = j * 256 + lane * 4;
    f32x4 gv = *(const f32x4*)(g + c), scv = *(const f32x4*)(sc + c), shv = *(const f32x4*)(sh + c);
    float o0 = xv[j * 4 + 0] * rstd * gv.x * (1.f + scv.x) + shv.x;
    float o1 = xv[j * 4 + 1] * rstd * gv.y * (1.f + scv.y) + shv.y;
    float o2 = xv[j * 4 + 2] * rstd * gv.z * (1.f + scv.z) + shv.z;
    float o3 = xv[j * 4 + 3] * rstd * gv.w * (1.f + scv.w) + shv.w;
    u32x2 o = {pk2(o0, o1), pk2(o2, o3)};
    *(u32x2*)(h + c) = o;
  }
}
DI void modnorm_phase(const Params& P, int l, int which) {
  const int lane = threadIdx.x & 63, wave = threadIdx.x >> 6;
  const bool from_in = (l == 0 && which == 0);
  const int stride = gridDim.x * 4;
  for (int t = blockIdx.x * 4 + wave; t < NTOK; t += 2 * stride) {
    const int t2 = t + stride;
    const bool has2 = t2 < NTOK;
    const int t2c = has2 ? t2 : t;
    const float* xrow = from_in ? ((t < NCTX) ? P.in[I_XP] + (size_t)t * 1024 : P.in[I_XS] + (size_t)(t - NCTX) * 1024) : P.out + O_X + (size_t)t * 1024;
    const float* xrow2 = from_in ? ((t2c < NCTX) ? P.in[I_XP] + (size_t)t2c * 1024 : P.in[I_XS] + (size_t)(t2c - NCTX) * 1024) : P.out + O_X + (size_t)t2c * 1024;
    float xv[16], xw[16];
#pragma unroll
    for (int j = 0; j < 4; ++j) {
      f32x4 v = *(const f32x4*)(xrow + j * 256 + lane * 4);
      f32x4 w = *(const f32x4*)(xrow2 + j * 256 + lane * 4);
      xv[j * 4] = v.x; xv[j * 4 + 1] = v.y; xv[j * 4 + 2] = v.z; xv[j * 4 + 3] = v.w;
      xw[j * 4] = w.x; xw[j * 4 + 1] = w.y; xw[j * 4 + 2] = w.z; xw[j * 4 + 3] = w.w;
    }
    modnorm_row_write(P, l, which, t, lane, xv);
    if (has2) modnorm_row_write(P, l, which, t2, lane, xw);
  }
}

template <class Epi>
DI void gemm_phase(const u16* __restrict__ A, const u16* __restrict__ Wt, int n_tiles, Epi epi, char* smem) {
  constexpr int BK = 64, LDK = 72, NKT = 1024 / BK;
  constexpr int A_ELEMS = 256 * LDK, B_ELEMS = 128 * LDK, STAGE = A_ELEMS + B_ELEMS;
  const int tid = threadIdx.x, lane = tid & 63, wave = tid >> 6;
  const int wm = wave >> 1, wn = wave & 1, r = lane & 31, h = lane >> 5;
  u16* sbase = (u16*)smem;
  float* sC = (float*)smem;
  const int crw = tid >> 3, ckc = (tid & 7) * 8;
  const int xcd = blockIdx.x & 7, nloc = gridDim.x >> 3;
  for (int q = blockIdx.x >> 3; q < 12 * n_tiles; q += nloc) {
    const int mt = xcd * 12 + q / n_tiles, nt = q % n_tiles;
    const u16* Ab = A + (size_t)mt * 256 * 1024 + (size_t)crw * 1024 + ckc;
    const u16* Bb = Wt + (size_t)nt * 128 * 1024 + (size_t)crw * 1024 + ckc;
    f32x16 acc[4][2];
#pragma unroll
    for (int i = 0; i < 4; ++i)
#pragma unroll
      for (int j = 0; j < 2; ++j)
#pragma unroll
        for (int g = 0; g < 16; ++g) acc[i][j][g] = 0.f;
    u32x4 ra[8], rb[4];
#pragma unroll
    for (int j = 0; j < 8; ++j) ra[j] = *(const u32x4*)(Ab + (size_t)j * 32 * 1024);
#pragma unroll
    for (int j = 0; j < 4; ++j) rb[j] = *(const u32x4*)(Bb + (size_t)j * 32 * 1024);
#pragma unroll
    for (int j = 0; j < 8; ++j) *(u32x4*)(sbase + (crw + 32 * j) * LDK + ckc) = ra[j];
#pragma unroll
    for (int j = 0; j < 4; ++j) *(u32x4*)(sbase + A_ELEMS + (crw + 32 * j) * LDK + ckc) = rb[j];
#pragma unroll
    for (int j = 0; j < 8; ++j) ra[j] = *(const u32x4*)(Ab + (size_t)j * 32 * 1024 + BK);
#pragma unroll
    for (int j = 0; j < 4; ++j) rb[j] = *(const u32x4*)(Bb + (size_t)j * 32 * 1024 + BK);
    __syncthreads();
    for (int kt = 0; kt < NKT; ++kt) {
      const u16* sA = sbase + (kt & 1) * STAGE;
      const u16* sB = sA + A_ELEMS;
      u16* sAn = sbase + ((kt & 1) ^ 1) * STAGE;
      u16* sBn = sAn + A_ELEMS;
#pragma unroll
      for (int ks = 0; ks < 4; ++ks) {
        bf16x8 a[4], b[2];
#pragma unroll
        for (int i = 0; i < 4; ++i) a[i] = ld8(sA + (wm * 128 + i * 32 + r) * LDK + ks * 16 + h * 8);
#pragma unroll
        for (int j = 0; j < 2; ++j) b[j] = ld8(sB + (wn * 64 + j * 32 + r) * LDK + ks * 16 + h * 8);
#pragma unroll
        for (int i = 0; i < 4; ++i)
#pragma unroll
          for (int j = 0; j < 2; ++j) acc[i][j] = MFMA(a[i], b[j], acc[i][j]);
        if (ks == 0 && kt + 1 < NKT) {
#pragma unroll
          for (int j = 0; j < 8; ++j) *(u32x4*)(sAn + (crw + 32 * j) * LDK + ckc) = ra[j];
#pragma unroll
          for (int j = 0; j < 4; ++j) *(u32x4*)(sBn + (crw + 32 * j) * LDK + ckc) = rb[j];
          if (kt + 2 < NKT) {
#pragma unroll
            for (int j = 0; j < 8; ++j) ra[j] = *(const u32x4*)(Ab + (size_t)j * 32 * 1024 + (kt + 2) * BK);
#pragma unroll
            for (int j = 0; j < 4; ++j) rb[j] = *(const u32x4*)(Bb + (size_t)j * 32 * 1024 + (kt + 2) * BK);
          }
        }
      }
      __syncthreads();
    }
#pragma unroll
    for (int i = 0; i < 4; ++i)
#pragma unroll
      for (int j = 0; j < 2; ++j)
#pragma unroll
        for (int g = 0; g < 16; ++g)
          sC[(wm * 128 + i * 32 + crow(g, h)) * 129 + wn * 64 + j * 32 + r] = acc[i][j][g];
    __syncthreads();
    epi(mt * 2, nt, sC);
    epi(mt * 2 + 1, nt, sC + 128 * 129);
    __syncthreads();
  }
}

DI void load32(const float* sC, int base, float (&v)[32]) {
#pragma unroll
  for (int j = 0; j < 32; ++j) v[j] = sC[base + j];
}
DI void headnorm_rope32(float (&v)[32], int a, const float* __restrict__ gain, bool rope, int s, const float* __restrict__ rt, float scale) {
  float ss = 0;
#pragma unroll
  for (int d = 0; d < 32; ++d) ss += v[d] * v[d];
  ss += __shfl_xor(ss, 1);
  float rstd = rsqrtf(ss * (1.f / 64.f) + EPS);
#pragma unroll
  for (int d = 0; d < 32; ++d) v[d] = v[d] * rstd * gain[a * 32 + d];
  if (rope) {
    const float* tb = rt + (a == 0 ? (s >> 6) : (s & 63)) * 32;
#pragma unroll
    for (int f = 0; f < 16; ++f) {
      float cs = tb[f * 2], sn = tb[f * 2 + 1];
      float x1 = v[f], x2 = v[16 + f];
      v[f] = x1 * cs - x2 * sn;
      v[16 + f] = x2 * cs + x1 * sn;
    }
  }
#pragma unroll
  for (int d = 0; d < 32; ++d) v[d] *= scale;
}
DI void store32_bf16(u16* dst, const float (&v)[32]) {
#pragma unroll
  for (int j = 0; j < 4; ++j) {
    u32x4 o = {pk2(v[j * 8], v[j * 8 + 1]), pk2(v[j * 8 + 2], v[j * 8 + 3]), pk2(v[j * 8 + 4], v[j * 8 + 5]), pk2(v[j * 8 + 6], v[j * 8 + 7])};
    *(u32x4*)(dst + j * 8) = o;
  }
}
DI void store32_f32(float* dst, const float (&v)[32]) {
#pragma unroll
  for (int j = 0; j < 8; ++j) {
    f32x4 o = {v[j * 4], v[j * 4 + 1], v[j * 4 + 2], v[j * 4 + 3]};
    *(f32x4*)(dst + j * 4) = o;
  }
}

struct EpiEvenIn {
  const Params* P; int i;
  DI void operator()(int mt, int nt, const float* sC) const {
    const Params& p = *P; char* ws = p.ws;
    const int tid = threadIdx.x;
    const int t0 = mt * 128;
    int isdec, b, s0, mi; tokinfo(t0, isdec, b, s0, mi);
    const float* rt = (const float*)(ws + W_ROPE);
    if (nt == 5) {
      const int c = tid & 127, tg = tid >> 7, kv = c >> 6, d = c & 63;
#pragma unroll 1
      for (int q = 0; q < 2; ++q) {
        const int tk = (q * 2 + tg) * 32;
        float v[32];
#pragma unroll
        for (int j = 0; j < 32; ++j) v[j] = sC[(tk + j) * 129 + c];
        const int s = s0 + tk;
        if (isdec) {
          store32_bf16((u16*)(ws + W_VAT_DEC + i * SZ_KA_DEC) + ((size_t)(b * 2 + kv) * 64 + d) * 4608 + s, v);
        } else {
          store32_bf16((u16*)(ws + W_VAT_CTX) + ((size_t)(b * 2 + kv) * 64 + d) * 256 + s, v);
          float* o = p.out + O_CAV + ((((size_t)b * 2 + i) * 256 + s) * 2 + kv) * 64 + d;
#pragma unroll
          for (int j = 0; j < 32; ++j) o[(size_t)j * 128] = v[j];
        }
      }
      return;
    }
    const int row = tid >> 1, a = tid & 1;
    const int t = t0 + row, s = s0 + row;
#pragma unroll 1
    for (int seg = 0; seg < 2; ++seg) {
      if (nt == 18 && seg == 1) break;
      float v[32];
      load32(sC, row * 129 + seg * 64 + a * 32, v);
      if (nt < 4) {
        int head = nt * 2 + seg;
        headnorm_rope32(v, a, p.in[I_AQN] + i * 64, isdec, s, rt, QSCALE);
        store32_bf16((u16*)(ws + W_Q) + (size_t)t * 1024 + head * 64 + a * 32, v);
      } else if (nt == 4) {
        int kv = seg;
        headnorm_rope32(v, a, p.in[I_AKN] + i * 64, isdec, s, rt, 1.f);
        if (isdec) {
          store32_bf16((u16*)(ws + W_KA_DEC + i * SZ_KA_DEC) + ((size_t)(b * 2 + kv) * 4608 + s) * 64 + a * 32, v);
        } else {
          store32_bf16((u16*)(ws + W_KA_CTX) + ((size_t)(b * 2 + kv) * 256 + s) * 64 + a * 32, v);
          store32_f32(p.out + O_CAK + ((((size_t)b * 2 + i) * 256 + s) * 2 + kv) * 64 + a * 32, v);
        }
      } else if (nt < 8) {
#pragma unroll
        for (int j = 0; j < 32; ++j) v[j] *= 0.125f;
        store32_bf16((u16*)(ws + W_BQ) + (size_t)t * 256 + (nt - 6) * 128 + seg * 64 + a * 32, v);
      } else if (nt < 10) {
        store32_bf16((u16*)(ws + W_BK) + (size_t)t * 256 + (nt - 8) * 128 + seg * 64 + a * 32, v);
      } else if (nt < 14) {
        store32_bf16((u16*)(ws + W_BV) + (size_t)t * 512 + (nt - 10) * 128 + seg * 64 + a * 32, v);
      } else if (nt < 18) {
        store32_bf16((u16*)(ws + W_BR) + (size_t)t * 512 + (nt - 14) * 128 + seg * 64 + a * 32, v);
      } else {
        if (a == 0) store32_f32((float*)(ws + W_BG) + (size_t)t * 32, v);
      }
    }
  }
};

struct EpiOddIn {
  const Params* P; int i;
  DI void operator()(int mt, int nt, const float* sC) const {
    const Params& p = *P; char* ws = p.ws;
    const int tid = threadIdx.x;
    const int t0 = mt * 128;
    int isdec, b, s0, mi; tokinfo(t0, isdec, b, s0, mi);
    const float* rt = (const float*)(ws + W_ROPE);
    if (nt >= 16) {
      const int c = tid & 127, tg = tid >> 7, hd = nt - 16;
#pragma unroll 1
      for (int q = 0; q < 2; ++q) {
        const int tk = (q * 2 + tg) * 32;
        float v[32];
#pragma unroll
        for (int j = 0; j < 32; ++j) v[j] = sC[(tk + j) * 129 + c];
        const int s = s0 + tk;
        if (isdec) {
          store32_bf16((u16*)(ws + W_VCT_DEC + i * SZ_KC_DEC) + ((size_t)(b * 8 + hd) * 128 + c) * 4608 + s, v);
        } else {
          store32_bf16((u16*)(ws + W_VCT_CTX) + ((size_t)(b * 8 + hd) * 128 + c) * 256 + s, v);
          float* o = p.out + O_CCV + ((((size_t)b * 2 + i) * 256 + s) * 8 + hd) * 128 + c;
#pragma unroll
          for (int j = 0; j < 32; ++j) o[(size_t)j * 1024] = v[j];
        }
      }
      return;
    }
    const int row = tid >> 1, a = tid & 1;
    const int t = t0 + row, s = s0 + row;
#pragma unroll 1
    for (int seg = 0; seg < 2; ++seg) {
      float v[32];
      load32(sC, row * 129 + seg * 64 + a * 32, v);
      if (nt < 8) {
        headnorm_rope32(v, a, p.in[I_CQN] + i * 64, isdec, s, rt, QSCALE);
        store32_bf16((u16*)(ws + W_Q) + (size_t)t * 1024 + nt * 128 + seg * 64 + a * 32, v);
      } else {
        int hd = nt - 8, m = seg;
        headnorm_rope32(v, a, p.in[I_CKN] + i * 64, isdec, s, rt, 1.f);
        if (isdec) {
          store32_bf16((u16*)(ws + W_KC_DEC + i * SZ_KC_DEC) + (((size_t)(b * 8 + hd) * 2 + m) * 4608 + s) * 64 + a * 32, v);
        } else {
          store32_bf16((u16*)(ws + W_KC_CTX) + (((size_t)(b * 8 + hd) * 2 + m) * 256 + s) * 64 + a * 32, v);
          store32_f32(p.out + O_CCK + (((((size_t)b * 2 + i) * 256 + s) * 8 + hd) * 2 + m) * 64 + a * 32, v);
        }
      }
    }
  }
};

struct EpiOut {
  const Params* P; int l;
  DI void operator()(int mt, int nt, const float* sC) const {
    const Params& p = *P;
    const int tid = threadIdx.x;
    const int t0 = mt * 128;
    int isdec, b, s0, mi; tokinfo(t0, isdec, b, s0, mi);
    const int c = (tid & 31) * 4;
    const float* g1 = (const float*)(p.ws + W_MOD) + ((size_t)l * 5 + mi) * 6144 + 2 * 1024 + nt * 128 + c;
    f32x4 gv = *(const f32x4*)g1;
    float* x = p.out + O_X;
    const float* xin = (l != 0) ? (const float*)x : ((t0 < NCTX) ? p.in[I_XP] : p.in[I_XS] - (size_t)NCTX * 1024);
#pragma unroll
    for (int j = 0; j < 16; ++j) {
      int row = (tid >> 5) + 8 * j;
      f32x4* xp = (f32x4*)(x + (size_t)(t0 + row) * 1024 + nt * 128 + c);
      f32x4 xv = *(const f32x4*)(xin + (size_t)(t0 + row) * 1024 + nt * 128 + c);
      const float* cc = sC + row * 129 + c;
      xv.x += gv.x * cc[0]; xv.y += gv.y * cc[1]; xv.z += gv.z * cc[2]; xv.w += gv.w * cc[3];
      *xp = xv;
    }
  }
};

struct EpiPQ {
  const Params* P;
  DI void operator()(int mt, int nt, const float* sC) const {
    const int tid = threadIdx.x;
    const int c = (tid & 31) * 4;
    u16* q = (u16*)(P->ws + W_Q);
#pragma unroll
    for (int j = 0; j < 16; ++j) {
      int row = (tid >> 5) + 8 * j;
      const float* cc = sC + row * 129 + c;
      u32x2 o = {pk2(cc[0], cc[1]), pk2(cc[2], cc[3])};
      *(u32x2*)(q + (size_t)(mt * 128 + row) * 1024 + nt * 128 + c) = o;
    }
  }
};

template <int DV, bool DIFF, int QG>
DI void attn_item(const u16* __restrict__ Qb  , const u16* __restrict__ Kb, size_t kmap_stride,
                  const u16* __restrict__ VT, int vt_stride, int ta0, int ta1, int tb0, int tb1, bool window, int qpos0,
                  float Mb, float sinkp, float lam, const float* __restrict__ onorm, float oscale,
                  u16* __restrict__ Ob  , char* smem) {
  constexpr int RB = DV / 32;
  constexpr int KMAPS = DIFF ? 2 : 1;
  constexpr int KBUF = KMAPS * 64 * 72, VBUF = DV * 72;
  const int tid = threadIdx.x, lane = tid & 63, wave = tid >> 6, r = lane & 31, h = lane >> 5;
  const int mw = DIFF ? (wave >> 1) : 0;
  const int qrow0 = DIFF ? ((wave & 1) * QG * 32 + r) : (wave * QG * 32 + r);
  u16* sK = (u16*)smem;
  u16* sV = sK + 2 * KBUF;
  const int c0 = tid, c1 = tid + 256, c2 = tid + 512, c3 = tid + 768;
  bf16x8 qf[QG][4];
#pragma unroll
  for (int qg = 0; qg < QG; ++qg)
#pragma unroll
    for (int ks = 0; ks < 4; ++ks) qf[qg][ks] = ld8(Qb + (size_t)(qrow0 + qg * 32) * 1024 + mw * 64 + ks * 16 + h * 8);
  f32x16 acc[QG][RB];
  float lrun[QG];
#pragma unroll
  for (int qg = 0; qg < QG; ++qg) {
#pragma unroll
    for (int rb = 0; rb < RB; ++rb)
#pragma unroll
      for (int g = 0; g < 16; ++g) acc[qg][rb][g] = 0.f;
    lrun[qg] = (h == 0) ? sinkp : 0.f;
  }
  const int na = ta1 - ta0, ntl = na + (tb1 - tb0);
  u32x4 st0, st1, st2, st3;
  {
    const int tile = (0 < na) ? ta0 : tb0;
    const u16* kp = Kb + (size_t)tile * 64 * 64;
    st0 = *(const u32x4*)(kp + (size_t)(c0 >> 3) * 64 + (c0 & 7) * 8);
    st1 = *(const u32x4*)(kp + (size_t)(c1 >> 3) * 64 + (c1 & 7) * 8);
    if (KMAPS > 1) {
      st2 = *(const u32x4*)(kp + kmap_stride + (size_t)(c0 >> 3) * 64 + (c0 & 7) * 8);
      st3 = *(const u32x4*)(kp + kmap_stride + (size_t)(c1 >> 3) * 64 + (c1 & 7) * 8);
    }
    *(u32x4*)(sK + (c0 >> 3) * 72 + (c0 & 7) * 8) = st0;
    *(u32x4*)(sK + (c1 >> 3) * 72 + (c1 & 7) * 8) = st1;
    if (KMAPS > 1) {
      *(u32x4*)(sK + 64 * 72 + (c0 >> 3) * 72 + (c0 & 7) * 8) = st2;
      *(u32x4*)(sK + 64 * 72 + (c1 >> 3) * 72 + (c1 & 7) * 8) = st3;
    }
    const u16* vp = VT + (size_t)tile * 64;
    st0 = *(const u32x4*)(vp + (size_t)(c0 >> 3) * vt_stride + (c0 & 7) * 8);
    st1 = *(const u32x4*)(vp + (size_t)(c1 >> 3) * vt_stride + (c1 & 7) * 8);
    if (DV > 64) {
      st2 = *(const u32x4*)(vp + (size_t)(c2 >> 3) * vt_stride + (c2 & 7) * 8);
      st3 = *(const u32x4*)(vp + (size_t)(c3 >> 3) * vt_stride + (c3 & 7) * 8);
    }
    *(u32x4*)(sV + (c0 >> 3) * 72 + (c0 & 7) * 8) = st0;
    *(u32x4*)(sV + (c1 >> 3) * 72 + (c1 & 7) * 8) = st1;
    if (DV > 64) {
      *(u32x4*)(sV + (c2 >> 3) * 72 + (c2 & 7) * 8) = st2;
      *(u32x4*)(sV + (c3 >> 3) * 72 + (c3 & 7) * 8) = st3;
    }
  }
  for (int it = 0; it < ntl; ++it) {
    const int tile = (it < na) ? (ta0 + it) : (tb0 + it - na);
    const int cur = it & 1, nxt = cur ^ 1;
    const bool more = (it + 1 < ntl);
    const int ntile = (it + 1 < na) ? (ta0 + it + 1) : (tb0 + it + 1 - na);
    const u16* sKc = sK + cur * KBUF + mw * 64 * 72;
    const u16* sVc = sV + cur * VBUF;
    __syncthreads();
    if (more) {
      const u16* kp = Kb + (size_t)ntile * 64 * 64;
      st0 = *(const u32x4*)(kp + (size_t)(c0 >> 3) * 64 + (c0 & 7) * 8);
      st1 = *(const u32x4*)(kp + (size_t)(c1 >> 3) * 64 + (c1 & 7) * 8);
      if (KMAPS > 1) {
        st2 = *(const u32x4*)(kp + kmap_stride + (size_t)(c0 >> 3) * 64 + (c0 & 7) * 8);
        st3 = *(const u32x4*)(kp + kmap_stride + (size_t)(c1 >> 3) * 64 + (c1 & 7) * 8);
      }
    }
    const bool domask = window && (it < na);
    f32x16 s[QG][2];
#pragma unroll
    for (int kb = 0; kb < 2; ++kb) {
#pragma unroll
      for (int qg = 0; qg < QG; ++qg)
#pragma unroll
        for (int g = 0; g < 16; ++g) s[qg][kb][g] = -Mb;
#pragma unroll
      for (int ks = 0; ks < 4; ++ks) {
        bf16x8 a = ld8(sKc + (kb * 32 + pi32(r)) * 72 + ks * 16 + h * 8);
#pragma unroll
        for (int qg = 0; qg < QG; ++qg) s[qg][kb] = MFMA(a, qf[qg][ks], s[qg][kb]);
      }
    }
    bf16x8 pf[QG][2][2];
#pragma unroll
    for (int qg = 0; qg < QG; ++qg) {
      if (domask) {
        const int qpos = qpos0 + qrow0 + qg * 32;
#pragma unroll
        for (int kb = 0; kb < 2; ++kb)
#pragma unroll
          for (int g = 0; g < 16; ++g) {
            int kpos = tile * 64 + kb * 32 + 16 * (g >> 3) + 8 * h + (g & 7);
            int dlt = qpos - kpos;
            if (dlt > 128 || dlt < -128) s[qg][kb][g] = -INFINITY;
          }
      }
      float ls = 0.f;
#pragma unroll
      for (int kb = 0; kb < 2; ++kb)
#pragma unroll
        for (int g = 0; g < 16; ++g) { float pv = __builtin_amdgcn_exp2f(s[qg][kb][g]); s[qg][kb][g] = pv; ls += pv; }
      lrun[qg] += ls;
#pragma unroll
      for (int kb = 0; kb < 2; ++kb)
#pragma unroll
        for (int s2 = 0; s2 < 2; ++s2) {
          u32x4 u = {pk2(s[qg][kb][8 * s2], s[qg][kb][8 * s2 + 1]), pk2(s[qg][kb][8 * s2 + 2], s[qg][kb][8 * s2 + 3]),
                     pk2(s[qg][kb][8 * s2 + 4], s[qg][kb][8 * s2 + 5]), pk2(s[qg][kb][8 * s2 + 6], s[qg][kb][8 * s2 + 7])};
          pf[qg][kb][s2] = __builtin_bit_cast(bf16x8, u);
        }
    }
    if (more) {
      u16* sKn = sK + nxt * KBUF;
      *(u32x4*)(sKn + (c0 >> 3) * 72 + (c0 & 7) * 8) = st0;
      *(u32x4*)(sKn + (c1 >> 3) * 72 + (c1 & 7) * 8) = st1;
      if (KMAPS > 1) {
        *(u32x4*)(sKn + 64 * 72 + (c0 >> 3) * 72 + (c0 & 7) * 8) = st2;
        *(u32x4*)(sKn + 64 * 72 + (c1 >> 3) * 72 + (c1 & 7) * 8) = st3;
      }
      const u16* vp = VT + (size_t)ntile * 64;
      st0 = *(const u32x4*)(vp + (size_t)(c0 >> 3) * vt_stride + (c0 & 7) * 8);
      st1 = *(const u32x4*)(vp + (size_t)(c1 >> 3) * vt_stride + (c1 & 7) * 8);
      if (DV > 64) {
        st2 = *(const u32x4*)(vp + (size_t)(c2 >> 3) * vt_stride + (c2 & 7) * 8);
        st3 = *(const u32x4*)(vp + (size_t)(c3 >> 3) * vt_stride + (c3 & 7) * 8);
      }
    }
#pragma unroll
    for (int rb = 0; rb < RB; ++rb)
#pragma unroll
      for (int kb = 0; kb < 2; ++kb)
#pragma unroll
        for (int s2 = 0; s2 < 2; ++s2) {
          bf16x8 v = ld8(sVc + (rb * 32 + r) * 72 + kb * 32 + s2 * 16 + h * 8);
#pragma unroll
          for (int qg = 0; qg < QG; ++qg) acc[qg][rb] = MFMA(v, pf[qg][kb][s2], acc[qg][rb]);
        }
    if (more) {
      u16* sVn = sV + nxt * VBUF;
      *(u32x4*)(sVn + (c0 >> 3) * 72 + (c0 & 7) * 8) = st0;
      *(u32x4*)(sVn + (c1 >> 3) * 72 + (c1 & 7) * 8) = st1;
      if (DV > 64) {
        *(u32x4*)(sVn + (c2 >> 3) * 72 + (c2 & 7) * 8) = st2;
        *(u32x4*)(sVn + (c3 >> 3) * 72 + (c3 & 7) * 8) = st3;
      }
    }
  }
  float inv[QG];
#pragma unroll
  for (int qg = 0; qg < QG; ++qg) { const float lt = lrun[qg] + __shfl_xor(lrun[qg], 32); inv[qg] = 1.f / lt; }
  if (!DIFF) {
#pragma unroll
    for (int qg = 0; qg < QG; ++qg) {
      u16* orow = Ob + (size_t)(qrow0 + qg * 32) * 1024;
#pragma unroll
      for (int rb = 0; rb < RB; ++rb)
#pragma unroll
        for (int g4 = 0; g4 < 4; ++g4) {
          u32x2 o = {pk2(acc[qg][rb][g4 * 4] * inv[qg], acc[qg][rb][g4 * 4 + 1] * inv[qg]),
                     pk2(acc[qg][rb][g4 * 4 + 2] * inv[qg], acc[qg][rb][g4 * 4 + 3] * inv[qg])};
          *(u32x2*)(orow + rb * 32 + 8 * g4 + 4 * h) = o;
        }
    }
    __syncthreads();
  } else {
    float* sX = (float*)smem;
    __syncthreads();
    if (mw == 1) {
#pragma unroll
      for (int qg = 0; qg < QG; ++qg) {
        const float c1f = lam * inv[qg];
#pragma unroll
        for (int rb = 0; rb < RB; ++rb)
#pragma unroll
          for (int g = 0; g < 16; ++g) sX[((((wave & 1) * QG + qg) * RB + rb) * 16 + g) * 64 + lane] = acc[qg][rb][g] * c1f;
      }
    }
    __syncthreads();
    if (mw == 0) {
#pragma unroll
      for (int qg = 0; qg < QG; ++qg) {
        float ss = 0.f;
#pragma unroll
        for (int rb = 0; rb < RB; ++rb)
#pragma unroll
          for (int g = 0; g < 16; ++g) {
            float o = acc[qg][rb][g] * inv[qg] - sX[((((wave & 1) * QG + qg) * RB + rb) * 16 + g) * 64 + lane];
            acc[qg][rb][g] = o; ss += o * o;
          }
        ss += __shfl_xor(ss, 32);
        const float rstd = rsqrtf(ss * (1.f / DV) + EPS) * oscale;
        u16* orow = Ob + (size_t)(qrow0 + qg * 32) * 1024;
#pragma unroll
        for (int rb = 0; rb < RB; ++rb)
#pragma unroll
          for (int g4 = 0; g4 < 4; ++g4) {
            int dv = rb * 32 + 8 * g4 + 4 * h;
            f32x4 gn = *(const f32x4*)(onorm + dv);
            u32x2 o = {pk2(acc[qg][rb][g4 * 4] * rstd * gn.x, acc[qg][rb][g4 * 4 + 1] * rstd * gn.y),
                       pk2(acc[qg][rb][g4 * 4 + 2] * rstd * gn.z, acc[qg][rb][g4 * 4 + 3] * rstd * gn.w)};
            *(u32x2*)(orow + dv) = o;
          }
      }
    }
    __syncthreads();
  }
}

DI void attnA_item(const Params& P, int i, int item, char* smem) {
  char* ws = P.ws;
  const u16* Q = (const u16*)(ws + W_Q);
  u16* O = (u16*)(ws + W_OMIX);
  int t0, head, ta0, ta1, tb0, tb1, vts, qpos0; bool window;
  const u16* Kb; const u16* VT;
  if (item < 512) {
    int n = item & 15, b = item >> 7; head = (item >> 4) & 7;
    int kv = head >> 2;
    t0 = NCTX + b * 4096 + n * 256;
    Kb = (const u16*)(ws + W_KA_DEC + i * SZ_KA_DEC) + (size_t)(b * 2 + kv) * 4608 * 64;
    VT = (const u16*)(ws + W_VAT_DEC + i * SZ_KA_DEC) + (size_t)(b * 2 + kv) * 64 * 4608;
    ta0 = max(0, 4 * n - 2); ta1 = min(64, 4 * n + 6); tb0 = 64; tb1 = 72; vts = 4608; window = true; qpos0 = n * 256;
  } else {
    int it = item - 512;
    int b = it >> 3; head = it & 7;
    int kv = head >> 2;
    t0 = b * 256;
    Kb = (const u16*)(ws + W_KA_CTX) + (size_t)(b * 2 + kv) * 256 * 64;
    VT = (const u16*)(ws + W_VAT_CTX) + (size_t)(b * 2 + kv) * 64 * 256;
    ta0 = 0; ta1 = 4; tb0 = 0; tb1 = 0; vts = 256; window = false; qpos0 = 0;
  }
  float Mb = ((const float*)(ws + W_LAM))[2 + i];
  float sinkp = __builtin_amdgcn_exp2f(P.in[I_ASINK][i * 8 + head] * LOG2E - Mb);
  attn_item<64, false, 2>(Q + (size_t)t0 * 1024 + head * 64, Kb, 0, VT, vts, ta0, ta1, tb0, tb1, window, qpos0, Mb, sinkp, 0.f, nullptr, 1.f,
                          O + (size_t)t0 * 1024 + head * 64, smem);
}
DI void attnC_phase(const Params& P, int i, char* smem) {
  char* ws = P.ws;
  const u16* Q = (const u16*)(ws + W_Q);
  u16* O = (u16*)(ws + W_OMIX);
  const float lam = ((const float*)(ws + W_LAM))[i];
  const float oscale = 1.f - P.lam_init[i];
  const float* onorm = P.in[I_CON] + i * 128;
  const float Mb = ((const float*)(ws + W_LAM))[4 + i];
  const int xcd = blockIdx.x & 7, local = blockIdx.x >> 3, nloc = gridDim.x >> 3;
  for (int q = local; q < 4 * 32 + 64; q += nloc) {
    int t0, head, nt, tk;
    const u16* Kb; const u16* VT;
    if (q < 128) {
      const int pair = xcd + 8 * (q >> 5), n = q & 31, b = pair >> 3; head = pair & 7;
      t0 = NCTX + b * 4096 + n * 128;
      Kb = (const u16*)(ws + W_KC_DEC + i * SZ_KC_DEC) + (size_t)(b * 8 + head) * 2 * 4608 * 64;
      VT = (const u16*)(ws + W_VCT_DEC + i * SZ_KC_DEC) + (size_t)(b * 8 + head) * 128 * 4608;
      nt = 72; tk = 4608;
    } else {
      const int it = q - 128;
      const int pair = xcd + 8 * (it >> 1), n = it & 1, b = pair >> 3; head = pair & 7;
      t0 = b * 256 + n * 128;
      Kb = (const u16*)(ws + W_KC_CTX) + (size_t)(b * 8 + head) * 2 * 256 * 64;
      VT = (const u16*)(ws + W_VCT_CTX) + (size_t)(b * 8 + head) * 128 * 256;
      nt = 4; tk = 256;
    }
    attn_item<128, true, 2>(Q + (size_t)t0 * 1024 + head * 128, Kb, (size_t)tk * 64, VT, tk, 0, nt, 0, 0, false, 0, Mb, 0.f, lam, onorm, oscale,
                            O + (size_t)t0 * 1024 + head * 128, smem);
  }
}

DI float log_sigmoid_f(float z) { return fminf(z, 0.f) - log1pf(__expf(-fabsf(z))); }

DI void gla_gates(const Params& P, int i, int hd, int dir, const float* sBG, float* sB) {
  const int tid = threadIdx.x, d = tid & 63, jq = tid >> 6;
  const float* gw = P.in[dir ? I_GWB : I_GWF] + (size_t)i * 16 * 256 + hd * 64 + d;
  const float gb = P.in[dir ? I_GBB : I_GBF][i * 256 + hd * 64 + d];
  float w[16];
#pragma unroll
  for (int rr = 0; rr < 16; ++rr) w[rr] = gw[rr * 256];
  for (int j = jq * 16; j < jq * 16 + 16; ++j) {
    float z = gb;
#pragma unroll
    for (int rr = 0; rr < 16; ++rr) z += sBG[j * 33 + dir * 16 + rr] * w[rr];
    sB[j * 65 + d] = log_sigmoid_f(z) * (1.f / 16.f);
  }
  __syncthreads();
  if (tid < 64) {
    float run = 0.f;
    if (dir == 0) { for (int j = 0; j < 64; ++j) { run += sB[j * 65 + tid]; sB[j * 65 + tid] = run; } }
    else { for (int j = 63; j >= 0; --j) { run += sB[j * 65 + tid]; sB[j * 65 + tid] = run; } }
  }
  __syncthreads();
}
DI void gla_load_common(const Params& P, int t0, int hd, float* sBG, u16* sVT) {
  const int tid = threadIdx.x;
  const float* bg = (const float*)(P.ws + W_BG) + (size_t)t0 * 32;
  for (int idx = tid; idx < 2048; idx += 256) sBG[(idx >> 5) * 33 + (idx & 31)] = bg[idx];
  {
    int j = tid & 63, vg = tid >> 6;
    const u16* src = (const u16*)(P.ws + W_BV) + (size_t)(t0 + j) * 512 + hd * 128 + vg * 32;
#pragma unroll
    for (int q = 0; q < 4; ++q) {
      u32x4 u = *(const u32x4*)(src + q * 8);
      unsigned w4[4] = {u.x, u.y, u.z, u.w};
#pragma unroll
      for (int e = 0; e < 4; ++e) {
        sVT[(vg * 32 + q * 8 + e * 2) * 72 + j] = (u16)(w4[e] & 0xffffu);
        sVT[(vg * 32 + q * 8 + e * 2 + 1) * 72 + j] = (u16)(w4[e] >> 16);
      }
    }
  }
}

DI void gla_b1_item(const Params& P, int i, int item, char* smem) {
  const int cgk = item >> 2, hd = item & 3, t0 = cgk * 64;
  const int tid = threadIdx.x, lane = tid & 63, wave = tid >> 6, r = lane & 31, h = lane >> 5;
  u16* sVT = (u16*)smem;
  float* sBG = (float*)(smem + 18432);
  float* sB = (float*)(smem + 18432 + 8448);
  u16* sKT = (u16*)(smem + 18432 + 8448 + 16640);
  gla_load_common(P, t0, hd, sBG, sVT);
  __syncthreads();
  for (int dir = 0; dir < 2; ++dir) {
    gla_gates(P, i, hd, dir, sBG, sB);
    {
      int d = tid & 63, jq = tid >> 6;
      float tot = (dir == 0) ? sB[63 * 65 + d] : sB[d];
      const u16* kp = (const u16*)(P.ws + W_BK) + (size_t)t0 * 256 + hd * 64 + d;
      for (int j = jq * 16; j < jq * 16 + 16; ++j) {
        float kvv = bf2f(kp[(size_t)j * 256]);
        sKT[d * 72 + j] = f2bf(kvv * __expf(tot - sB[j * 65 + d]));
      }
      if (jq == 0) ((float*)(P.ws + W_DEC))[((size_t)item * 2 + dir) * 64 + d] = __expf(tot);
    }
    __syncthreads();
    {
      int dblk = wave >> 1, vh = wave & 1;
      f32x16 acc[2];
#pragma unroll
      for (int jv = 0; jv < 2; ++jv)
#pragma unroll
        for (int g = 0; g < 16; ++g) acc[jv][g] = 0.f;
#pragma unroll
      for (int ks = 0; ks < 4; ++ks) {
        bf16x8 a = ld8(sKT + (dblk * 32 + r) * 72 + ks * 16 + h * 8);
#pragma unroll
        for (int jv = 0; jv < 2; ++jv) {
          bf16x8 bb = ld8(sVT + (vh * 64 + jv * 32 + r) * 72 + ks * 16 + h * 8);
          acc[jv] = MFMA(a, bb, acc[jv]);
        }
      }
      float* kvo = (float*)(P.ws + W_KV) + ((size_t)item * 2 + dir) * 8192;
#pragma unroll
      for (int jv = 0; jv < 2; ++jv)
#pragma unroll
        for (int g = 0; g < 16; ++g) kvo[(dblk * 32 + crow(g, h)) * 128 + vh * 64 + jv * 32 + r] = acc[jv][g];
    }
    __syncthreads();
  }
}

DI void gla_scan_phase(const Params& P, int i) {
  const int tid = threadIdx.x;
  for (int item = blockIdx.x; item < 36 * 4 * 2 * 8; item += gridDim.x) {
    int slab = item & 7, dir = (item >> 3) & 1, hd = (item >> 4) & 3, seq = item >> 6;
    int cg0, NC, b, isdec;
    if (seq < 32) { isdec = 0; b = seq; cg0 = b * 4; NC = 4; } else { isdec = 1; b = seq - 32; cg0 = 128 + b * 64; NC = 64; }
    int e = slab * 1024 + tid * 4, d = e >> 7;
    f32x4 s = {0.f, 0.f, 0.f, 0.f};
    if (isdec) s = *(const f32x4*)(P.in[dir ? I_SBB : I_SBF] + (((size_t)b * 2 + i) * 4 + hd) * 8192 + e);
    float* kvb = (float*)(P.ws + W_KV);
    const float* decb = (const float*)(P.ws + W_DEC);
    for (int n4 = 0; n4 < NC; n4 += 4) {
      f32x4 tmp[4]; float dc[4];
#pragma unroll
      for (int u = 0; u < 4; ++u) {
        int n = dir ? (NC - 1 - (n4 + u)) : (n4 + u);
        size_t ci = ((size_t)(cg0 + n) * 4 + hd) * 2 + dir;
        tmp[u] = *(const f32x4*)(kvb + ci * 8192 + e);
        dc[u] = decb[ci * 64 + d];
      }
#pragma unroll
      for (int u = 0; u < 4; ++u) {
        int n = dir ? (NC - 1 - (n4 + u)) : (n4 + u);
        size_t ci = ((size_t)(cg0 + n) * 4 + hd) * 2 + dir;
        *(f32x4*)(kvb + ci * 8192 + e) = s;
        s.x = dc[u] * s.x + tmp[u].x; s.y = dc[u] * s.y + tmp[u].y; s.z = dc[u] * s.z + tmp[u].z; s.w = dc[u] * s.w + tmp[u].w;
      }
    }
    if (!isdec) *(f32x4*)(P.out + (dir ? O_SBB : O_SBF) + (((size_t)b * 2 + i) * 4 + hd) * 8192 + e) = s;
  }
}

DI void gla_b3_item(const Params& P, int i, int item, char* smem) {
  const int cgk = item >> 2, hd = item & 3, t0 = cgk * 64;
  const int tid = threadIdx.x, lane = tid & 63, wave = tid >> 6, r = lane & 31, h = lane >> 5;
  u16* sVT = (u16*)smem;
  u16* sA = (u16*)(smem + 18432);
  float* sBG = (float*)(smem + 27648);
  float* sB = (float*)(smem + 36096);
  u16* sQD = (u16*)(smem + 52736);
  u16* sKD = (u16*)(smem + 61952);
  float* sO = (float*)(smem + 36096);
  gla_load_common(P, t0, hd, sBG, sVT);
  __syncthreads();
  const int iblk = wave >> 1, jblk = wave & 1;
  f32x16 aacc[2], oacc[2];
#pragma unroll
  for (int u = 0; u < 2; ++u)
#pragma unroll
    for (int g = 0; g < 16; ++g) { aacc[u][g] = 0.f; oacc[u][g] = 0.f; }
#pragma unroll
  for (int dir = 0; dir < 2; ++dir) {
    gla_gates(P, i, hd, dir, sBG, sB);
    {
      int d = tid & 63, jq = tid >> 6;
      const u16* qp = (const u16*)(P.ws + W_BQ) + (size_t)t0 * 256 + hd * 64 + d;
      const u16* kp = (const u16*)(P.ws + W_BK) + (size_t)t0 * 256 + hd * 64 + d;
      for (int j = jq * 16; j < jq * 16 + 16; ++j) {
        float bb = sB[j * 65 + d];
        sQD[j * 72 + d] = f2bf(bf2f(qp[(size_t)j * 256]) * __expf(bb));
        sKD[j * 72 + d] = f2bf(bf2f(kp[(size_t)j * 256]) * __expf(-bb));
      }
    }
    __syncthreads();
#pragma unroll
    for (int ks = 0; ks < 4; ++ks) {
      bf16x8 a = ld8(sQD + (iblk * 32 + r) * 72 + ks * 16 + h * 8);
      bf16x8 bb = ld8(sKD + (jblk * 32 + r) * 72 + ks * 16 + h * 8);
      aacc[dir] = MFMA(a, bb, aacc[dir]);
    }
    const float* S = (const float*)(P.ws + W_KV) + ((size_t)item * 2 + dir) * 8192 + wave * 32 + r;
#pragma unroll
    for (int ks = 0; ks < 4; ++ks) {
      float sv[8];
#pragma unroll
      for (int jj = 0; jj < 8; ++jj) sv[jj] = S[(size_t)(ks * 16 + h * 8 + jj) * 128];
      u32x4 u = {pk2(sv[0], sv[1]), pk2(sv[2], sv[3]), pk2(sv[4], sv[5]), pk2(sv[6], sv[7])};
      bf16x8 bfr = __builtin_bit_cast(bf16x8, u);
#pragma unroll
      for (int it = 0; it < 2; ++it) {
        bf16x8 a = ld8(sQD + (it * 32 + r) * 72 + ks * 16 + h * 8);
        oacc[it] = MFMA(a, bfr, oacc[it]);
      }
    }
    __syncthreads();
  }
#pragma unroll
  for (int g = 0; g < 16; ++g) {
    int ii = iblk * 32 + crow(g, h), jj = jblk * 32 + r;
    float v = (jj <= ii ? aacc[0][g] : 0.f) + (jj >= ii ? aacc[1][g] : 0.f);
    sA[ii * 72 + jj] = f2bf(v);
  }
  __syncthreads();
#pragma unroll
  for (int ks = 0; ks < 4; ++ks) {
    bf16x8 bb = ld8(sVT + (wave * 32 + r) * 72 + ks * 16 + h * 8);
#pragma unroll
    for (int it = 0; it < 2; ++it) {
      bf16x8 a = ld8(sA + (it * 32 + r) * 72 + ks * 16 + h * 8);
      oacc[it] = MFMA(a, bb, oacc[it]);
    }
  }
#pragma unroll
  for (int it = 0; it < 2; ++it)
#pragma unroll
    for (int g = 0; g < 16; ++g) sO[(it * 32 + crow(g, h)) * 129 + wave * 32 + r] = oacc[it][g];
  __syncthreads();
  {
    int ii = tid >> 2, seg = tid & 3;
    float v[32]; float ss = 0.f;
#pragma unroll
    for (int c = 0; c < 32; ++c) { v[c] = sO[ii * 129 + seg * 32 + c]; ss += v[c] * v[c]; }
    ss += __shfl_xor(ss, 1); ss += __shfl_xor(ss, 2);
    float rstd = rsqrtf(ss * (1.f / 128.f) + EPS);
    const float* gn = P.in[I_BON] + i * 128 + seg * 32;
    const u16* br = (const u16*)(P.ws + W_BR) + (size_t)(t0 + ii) * 512 + hd * 128 + seg * 32;
    u16* o = (u16*)(P.ws + W_OMIX) + (size_t)(t0 + ii) * 1024 + 512 + hd * 128 + seg * 32;
#pragma unroll
    for (int q = 0; q < 4; ++q) {
      u32x4 bu = *(const u32x4*)(br + q * 8);
      unsigned bw[4] = {bu.x, bu.y, bu.z, bu.w};
      unsigned ow[4];
#pragma unroll
      for (int e = 0; e < 4; ++e) {
        int c = q * 8 + e * 2;
        float o0 = v[c] * rstd * gn[c] * silu_f(bflo(bw[e]));
        float o1 = v[c + 1] * rstd * gn[c + 1] * silu_f(bfhi(bw[e]));
        ow[e] = pk2(o0, o1);
      }
      u32x4 ou = {ow[0], ow[1], ow[2], ow[3]};
      *(u32x4*)(o + q * 8) = ou;
    }
  }
  __syncthreads();
}

DI unsigned f2key(float f) { unsigned b = __float_as_uint(f); return b ^ ((unsigned)((int)b >> 31) | 0x80000000u); }
DI float key2f(unsigned k) { unsigned b = (k & 0x80000000u) ? (k ^ 0x80000000u) : ~k; return __uint_as_float(b); }
DI void ce_desc(unsigned& x, unsigned& y) { unsigned mx = max(x, y), mn = min(x, y); x = mx; y = mn; }
template <int B, int N>
DI void sort16_desc(unsigned (&a)[N]) {
#pragma unroll
  for (int k = 2; k <= 16; k <<= 1)
#pragma unroll
    for (int j = k >> 1; j > 0; j >>= 1)
#pragma unroll
      for (int i = 0; i < 16; ++i) {
        const int l = i ^ j;
        if (l > i) {
          if ((i & k) == 0) ce_desc(a[B + i], a[B + l]); else ce_desc(a[B + l], a[B + i]);
        }
      }
}
template <int A, int Bo, int N>
DI void merge16_desc(unsigned (&a)[N]) {
#pragma unroll
  for (int i = 0; i < 16; ++i) a[A + i] = max(a[A + i], a[Bo + 15 - i]);
#pragma unroll
  for (int j = 8; j > 0; j >>= 1)
#pragma unroll
    for (int i = 0; i < 16; ++i) {
      const int l = i ^ j;
      if (l > i) ce_desc(a[A + i], a[A + l]);
    }
}
DI void top16_of_64(unsigned (&a)[64]) {
  sort16_desc<0>(a); sort16_desc<16>(a); sort16_desc<32>(a); sort16_desc<48>(a);
  merge16_desc<0, 16>(a); merge16_desc<32, 48>(a); merge16_desc<0, 32>(a);
}

DI void peer_topk_phase(const Params& P, int l, char* smem) {
  const int tid = threadIdx.x, lane = tid & 63, wave = tid >> 6, r = lane & 31, h = lane >> 5;
  const u16* Q = (const u16*)(P.ws + W_Q);
  const u16* SK = (const u16*)(P.ws + W_SK) + (size_t)l * 8 * 2 * 128 * 64;
  for (int wi = blockIdx.x * 4 + wave; wi < (NTOK / 32) * 8; wi += gridDim.x * 4) {
    const int hd = wi & 7, t0 = (wi >> 3) * 32;
    unsigned lst[2][16];
    f32x16 accp[2][4];
    {
      bf16x8 bq[2][4], ak[2][4][4];
#pragma unroll
      for (int p = 0; p < 2; ++p)
#pragma unroll
        for (int ks = 0; ks < 4; ++ks) {
          bq[p][ks] = ld8(Q + (size_t)(t0 + r) * 1024 + hd * 128 + p * 64 + ks * 16 + h * 8);
#pragma unroll
          for (int kt = 0; kt < 4; ++kt) ak[p][ks][kt] = ld8(SK + ((size_t)(hd * 2 + p) * 128 + kt * 32 + r) * 64 + ks * 16 + h * 8);
        }
#pragma unroll
      for (int p = 0; p < 2; ++p) {
#pragma unroll
        for (int kt = 0; kt < 4; ++kt)
#pragma unroll
          for (int g = 0; g < 16; ++g) accp[p][kt][g] = 0.f;
#pragma unroll
        for (int ks = 0; ks < 4; ++ks)
#pragma unroll
          for (int kt = 0; kt < 4; ++kt) accp[p][kt] = MFMA(ak[p][ks][kt], bq[p][ks], accp[p][kt]);
      }
    }
#pragma unroll
    for (int p = 0; p < 2; ++p) {
      f32x16 (&acc)[4] = accp[p];
      unsigned a[64];
#pragma unroll
      for (int kt = 0; kt < 4; ++kt)
#pragma unroll
        for (int g = 0; g < 16; ++g) {
          const int key = kt * 32 + crow(g, h);
          a[kt * 16 + g] = (f2key(acc[kt][g]) & ~127u) | (unsigned)(127 - key);
        }
      top16_of_64(a);
#pragma unroll
      for (int i = 0; i < 16; ++i) a[16 + i] = (unsigned)__shfl_xor((int)a[i], 32);
      merge16_desc<0, 16>(a);
#pragma unroll
      for (int i = 0; i < 16; ++i) lst[p][i] = a[i];
    }
    unsigned c[64];
    {
      float v0[16], v1[16];
#pragma unroll
      for (int k = 0; k < 16; ++k) { v0[k] = key2f(lst[0][k] & ~127u); v1[k] = key2f(lst[1][k] & ~127u); }
      int n = 0;
#pragma unroll
      for (int a = 0; a < 16; ++a)
#pragma unroll
        for (int b = 0; b < 16; ++b)
          if ((a + 1) * (b + 1) <= 16) {
            const unsigned i0 = 127u - (lst[0][a] & 127u), i1 = 127u - (lst[1][b] & 127u);
            c[n] = (f2key(v0[a] + v1[b]) & 0xFFFFC000u) | (i0 << 7) | i1;
            ++n;
          }
#pragma unroll
      for (int k = 50; k < 64; ++k) c[k] = 0u;
    }
    top16_of_64(c);
    float fs[16];
    const float mx = key2f(c[0] & 0xFFFFC000u);
    float sum = 0.f;
#pragma unroll
    for (int k = 0; k < 16; ++k) { fs[k] = __expf(key2f(c[k] & 0xFFFFC000u) - mx); sum += fs[k]; }
    const float inv = 1.f / sum;
    const size_t ob = (size_t)(t0 + r) * 128 + hd * 16;
    if (h == 0) {
      int* eo = (int*)(P.ws + W_EIDX) + ob;
#pragma unroll
      for (int q = 0; q < 4; ++q) {
        u32x4 o = {c[q * 4] & 0x3FFFu, c[q * 4 + 1] & 0x3FFFu, c[q * 4 + 2] & 0x3FFFu, c[q * 4 + 3] & 0x3FFFu};
        *(u32x4*)(eo + q * 4) = o;
      }
    } else {
      float* go = (float*)(P.ws + W_EGATE) + ob;
#pragma unroll
      for (int q = 0; q < 4; ++q) {
        f32x4 o = {fs[q * 4] * inv, fs[q * 4 + 1] * inv, fs[q * 4 + 2] * inv, fs[q * 4 + 3] * inv};
        *(f32x4*)(go + q * 4) = o;
      }
    }
  }
}

DI float dpp_add(float e, float v, int) { return e + v; }
#define DPP_ADD(e, ctrl) ((e) + __int_as_float(__builtin_amdgcn_update_dpp(0, __float_as_int(e), (ctrl), 0xf, 0xf, true)))
DI float reduce4(float d0, float d1, float d2, float d3, int lane) {
  auto r01 = __builtin_amdgcn_permlane32_swap(__float_as_uint(d0), __float_as_uint(d1), false, false);
  const float a = __uint_as_float(r01[0]) + __uint_as_float(r01[1]);
  auto r23 = __builtin_amdgcn_permlane32_swap(__float_as_uint(d2), __float_as_uint(d3), false, false);
  const float c = __uint_as_float(r23[0]) + __uint_as_float(r23[1]);
  auto rq = __builtin_amdgcn_permlane16_swap(__float_as_uint(a), __float_as_uint(c), false, false);
  float e = __uint_as_float(rq[0]) + __uint_as_float(rq[1]);
  e = DPP_ADD(e, 0xB1);
  e = DPP_ADD(e, 0x4E);
  e = DPP_ADD(e, 0x141);
  e = DPP_ADD(e, 0x140);
  return e;
}
DI float dot16_fp8(const u32x4& w, const f32x2_t (&h2)[8]) {
  f32x2_t acc0 = {0.f, 0.f}, acc1 = {0.f, 0.f};
  acc0 = __builtin_amdgcn_cvt_pk_f32_fp8((int)w.x, false) * h2[0] + acc0;
  acc1 = __builtin_amdgcn_cvt_pk_f32_fp8((int)w.x, true) * h2[1] + acc1;
  acc0 = __builtin_amdgcn_cvt_pk_f32_fp8((int)w.y, false) * h2[2] + acc0;
  acc1 = __builtin_amdgcn_cvt_pk_f32_fp8((int)w.y, true) * h2[3] + acc1;
  acc0 = __builtin_amdgcn_cvt_pk_f32_fp8((int)w.z, false) * h2[4] + acc0;
  acc1 = __builtin_amdgcn_cvt_pk_f32_fp8((int)w.z, true) * h2[5] + acc1;
  acc0 = __builtin_amdgcn_cvt_pk_f32_fp8((int)w.w, false) * h2[6] + acc0;
  acc1 = __builtin_amdgcn_cvt_pk_f32_fp8((int)w.w, true) * h2[7] + acc1;
  acc0 += acc1;
  return acc0.x + acc0.y;
}
DI void axpy16_fp8(const u32x4& w, float s, f32x2_t (&y2)[8]) {
  const f32x2_t s2 = {s, s};
  y2[0] = __builtin_amdgcn_cvt_pk_f32_fp8((int)w.x, false) * s2 + y2[0];
  y2[1] = __builtin_amdgcn_cvt_pk_f32_fp8((int)w.x, true) * s2 + y2[1];
  y2[2] = __builtin_amdgcn_cvt_pk_f32_fp8((int)w.y, false) * s2 + y2[2];
  y2[3] = __builtin_amdgcn_cvt_pk_f32_fp8((int)w.y, true) * s2 + y2[3];
  y2[4] = __builtin_amdgcn_cvt_pk_f32_fp8((int)w.z, false) * s2 + y2[4];
  y2[5] = __builtin_amdgcn_cvt_pk_f32_fp8((int)w.z, true) * s2 + y2[5];
  y2[6] = __builtin_amdgcn_cvt_pk_f32_fp8((int)w.w, false) * s2 + y2[6];
  y2[7] = __builtin_amdgcn_cvt_pk_f32_fp8((int)w.w, true) * s2 + y2[7];
}

DI void axpy16_fp4(const u32x2& w, float s, f32x2_t (&y2)[8]) {
  const f32x2_t s2 = {s, s};
  y2[0] = __builtin_amdgcn_cvt_scalef32_pk_f32_fp4(w.x, 1.0f, 0) * s2 + y2[0];
  y2[1] = __builtin_amdgcn_cvt_scalef32_pk_f32_fp4(w.x, 1.0f, 1) * s2 + y2[1];
  y2[2] = __builtin_amdgcn_cvt_scalef32_pk_f32_fp4(w.x, 1.0f, 2) * s2 + y2[2];
  y2[3] = __builtin_amdgcn_cvt_scalef32_pk_f32_fp4(w.x, 1.0f, 3) * s2 + y2[3];
  y2[4] = __builtin_amdgcn_cvt_scalef32_pk_f32_fp4(w.y, 1.0f, 0) * s2 + y2[4];
  y2[5] = __builtin_amdgcn_cvt_scalef32_pk_f32_fp4(w.y, 1.0f, 1) * s2 + y2[5];
  y2[6] = __builtin_amdgcn_cvt_scalef32_pk_f32_fp4(w.y, 1.0f, 2) * s2 + y2[6];
  y2[7] = __builtin_amdgcn_cvt_scalef32_pk_f32_fp4(w.y, 1.0f, 3) * s2 + y2[7];
}
DI void peer_expert_phase(const Params& P, int l) {
  const int lane = threadIdx.x & 63, wave = threadIdx.x >> 6;
  const char* U = P.ws + W_PU + (size_t)l * 16384 * 1536 + lane * 16;
  const char* V = P.ws + W_PU + (size_t)l * 16384 * 1536 + 1024 + lane * 8;
  const float* SU = (const float*)(P.ws + W_PSU) + l * 16384;
  const float* SV = (const float*)(P.ws + W_PSV) + l * 16384;
  float* x = P.out + O_X;
  const int grp = lane >> 4;
  const int tstride = gridDim.x * 4;
  int ni0, ni1; float ng0, ng1; u32x4 nhA, nhB;
  {
    const int tl = min(blockIdx.x * 4 + wave, NTOK - 1);
    const u16* hrow = (const u16*)(P.ws + W_H) + (size_t)tl * 1024 + lane * 16;
    nhA = *(const u32x4*)hrow; nhB = *(const u32x4*)(hrow + 8);
    const int* ei = (const int*)(P.ws + W_EIDX) + (size_t)tl * 128;
    const float* eg = (const float*)(P.ws + W_EGATE) + (size_t)tl * 128;
    ni0 = ei[lane]; ni1 = ei[64 + lane]; ng0 = eg[lane]; ng1 = eg[64 + lane];
  }
  for (int t = blockIdx.x * 4 + wave; t < NTOK; t += tstride) {
    int isdec, b, s, mi; tokinfo(t, isdec, b, s, mi);
    const u32x4 hA = nhA, hB = nhB;
    const int myi0 = ni0, myi1 = ni1;
    const float graw0 = ng0, graw1 = ng1;
    {
      const int tn = min(t + tstride, NTOK - 1);
      const u16* hrow = (const u16*)(P.ws + W_H) + (size_t)tn * 1024 + lane * 16;
      nhA = *(const u32x4*)hrow; nhB = *(const u32x4*)(hrow + 8);
      const int* ei = (const int*)(P.ws + W_EIDX) + (size_t)tn * 128;
      const float* eg = (const float*)(P.ws + W_EGATE) + (size_t)tn * 128;
      ni0 = ei[lane]; ni1 = ei[64 + lane]; ng0 = eg[lane]; ng1 = eg[64 + lane];
    }
    f32x2_t h2[8] = {{bflo(hA.x), bfhi(hA.x)}, {bflo(hA.y), bfhi(hA.y)}, {bflo(hA.z), bfhi(hA.z)}, {bflo(hA.w), bfhi(hA.w)},
                     {bflo(hB.x), bfhi(hB.x)}, {bflo(hB.y), bfhi(hB.y)}, {bflo(hB.z), bfhi(hB.z)}, {bflo(hB.w), bfhi(hB.w)}};
    const float mysu0 = SU[myi0], mysu1 = SU[myi1];
    const float myg0 = graw0 * SV[myi0], myg1 = graw1 * SV[myi1];
    f32x2_t y2[8];
#pragma unroll
    for (int j = 0; j < 8; ++j) { y2[j].x = 0.f; y2[j].y = 0.f; }
    u32x4 un[16]; u32x2 vn[16];
#pragma unroll
    for (int u = 0; u < 16; ++u) {
      const int id = __builtin_amdgcn_readlane(myi0, u);
      un[u] = *(const u32x4*)(U + (size_t)id * 1536);
      vn[u] = *(const u32x2*)(V + (size_t)id * 1536);
    }
    for (int e0 = 0; e0 < 128; e0 += 16) {
      u32x4 uc[16]; u32x2 vc[16];
#pragma unroll
      for (int u = 0; u < 16; ++u) { uc[u] = un[u]; vc[u] = vn[u]; }
      if (e0 + 16 < 128) {
        const int e1 = e0 + 16;
        const int srci = (e1 < 64) ? myi0 : myi1;
#pragma unroll
        for (int u = 0; u < 16; ++u) {
          const int id = __builtin_amdgcn_readlane(srci, (e1 + u) & 63);
          un[u] = *(const u32x4*)(U + (size_t)id * 1536);
          vn[u] = *(const u32x2*)(V + (size_t)id * 1536);
        }
      }
      const float gsrc = (e0 < 64) ? myg0 : myg1;
      const float ssrc = (e0 < 64) ? mysu0 : mysu1;
#pragma unroll
      for (int hb = 0; hb < 4; ++hb) {
        float su[4], gt[4];
#pragma unroll
        for (int u = 0; u < 4; ++u) {
          su[u] = __int_as_float(__builtin_amdgcn_readlane(__float_as_int(ssrc), (e0 + hb * 4 + u) & 63));
          gt[u] = __int_as_float(__builtin_amdgcn_readlane(__float_as_int(gsrc), (e0 + hb * 4 + u) & 63));
        }
        float d0 = dot16_fp8(uc[hb * 4 + 0], h2), d1 = dot16_fp8(uc[hb * 4 + 1], h2), d2 = dot16_fp8(uc[hb * 4 + 2], h2), d3 = dot16_fp8(uc[hb * 4 + 3], h2);
        float e = reduce4(d0, d1, d2, d3, lane);
        const float su_s = (grp == 0) ? su[0] : (grp == 1) ? su[2] : (grp == 2) ? su[1] : su[3];
        const float w_s = (grp == 0) ? gt[0] : (grp == 1) ? gt[2] : (grp == 2) ? gt[1] : gt[3];
        const float pre = e * su_s;
        const float act = 0.5f * pre * (1.f + erff(pre * 0.70710678118654752f));
        const float w = act * w_s;
        const float w0 = __int_as_float(__builtin_amdgcn_readlane(__float_as_int(w), 0));
        const float w1 = __int_as_float(__builtin_amdgcn_readlane(__float_as_int(w), 32));
        const float w2 = __int_as_float(__builtin_amdgcn_readlane(__float_as_int(w), 16));
        const float w3 = __int_as_float(__builtin_amdgcn_readlane(__float_as_int(w), 48));
        axpy16_fp4(vc[hb * 4 + 0], w0, y2); axpy16_fp4(vc[hb * 4 + 1], w1, y2); axpy16_fp4(vc[hb * 4 + 2], w2, y2); axpy16_fp4(vc[hb * 4 + 3], w3, y2);
      }
    }
    const float* g2 = (const float*)(P.ws + W_MOD) + ((size_t)l * 5 + mi) * 6144 + 5 * 1024 + lane * 16;
    float* xr = x + (size_t)t * 1024 + lane * 16;
    float xn[16];
#pragma unroll
    for (int q = 0; q < 4; ++q) {
      f32x4 xv = *(const f32x4*)(xr + q * 4), gv = *(const f32x4*)(g2 + q * 4);
      xv.x += gv.x * y2[q * 2].x; xv.y += gv.y * y2[q * 2].y; xv.z += gv.z * y2[q * 2 + 1].x; xv.w += gv.w * y2[q * 2 + 1].y;
      *(f32x4*)(xr + q * 4) = xv;
      xn[q * 4] = xv.x; xn[q * 4 + 1] = xv.y; xn[q * 4 + 2] = xv.z; xn[q * 4 + 3] = xv.w;
    }
    if (l < 3) {
      float ss = 0.f;
#pragma unroll
      for (int j = 0; j < 16; ++j) ss += xn[j] * xn[j];
      ss = wave_sum(ss);
      float rstd = rsqrtf(ss * (1.f / 1024.f) + EPS);
      const float* g = P.in[I_NMG] + (l + 1) * 1024 + lane * 16;
      const float* mod = (const float*)(P.ws + W_MOD) + ((size_t)(l + 1) * 5 + mi) * 6144 + lane * 16;
      u16* hh = (u16*)(P.ws + W_H) + (size_t)t * 1024 + lane * 16;
#pragma unroll
      for (int hf = 0; hf < 2; ++hf) {
        float o[8];
#pragma unroll
        for (int q = 0; q < 8; ++q) o[q] = xn[hf * 8 + q] * rstd * g[hf * 8 + q] * (1.f + mod[1024 + hf * 8 + q]) + mod[hf * 8 + q];
        u32x4 ou = {pk2(o[0], o[1]), pk2(o[2], o[3]), pk2(o[4], o[5]), pk2(o[6], o[7])};
        *(u32x4*)(hh + hf * 8) = ou;
      }
    }
  }
}

DI void mixer1_phase(const Params& P, int i, char* smem) {
  const int xcd = blockIdx.x & 7, nloc = gridDim.x >> 3;
  for (int q = blockIdx.x >> 3; q < 96; q += nloc) {
    int item;
    if (q < 64) { const int b = xcd >> 1, head = (xcd & 1) * 4 + (q >> 4), n = q & 15; item = b * 128 + head * 16 + n; }
    else { const int it = q - 64, b = xcd + 8 * (it >> 3), head = it & 7; item = 512 + b * 8 + head; }
    attnA_item(P, i, item, smem);
  }
  for (int item = blockIdx.x; item < 1536; item += gridDim.x) gla_b1_item(P, i, item, smem);
}

#define XB_TMO      128
#define XB_XCNT(j)  (256  + 64 * (j))
#define XB_XSUB(j)  (1280 + 64 * (j))
#define XB_XGEN(j)  (2304 + 64 * (j))
#define XB_TOP      3328
#define XB_TOPGEN   3392
#define XCD_BAR_WORDS 3456
#define XB_SPIN_CAP (1u << 20)
#define LAS __attribute__((address_space(3)))
DI unsigned xb_ld(unsigned* p)              { return __hip_atomic_load(p, __ATOMIC_RELAXED, __HIP_MEMORY_SCOPE_AGENT); }
DI unsigned xb_add(unsigned* p, unsigned v) { return __hip_atomic_fetch_add(p, v, __ATOMIC_RELAXED, __HIP_MEMORY_SCOPE_AGENT); }
DI unsigned xb_xcc_id() { return (unsigned)__builtin_amdgcn_s_getreg((3 << 11) | 20) & 0xFu; }
#define XB_SPIN(cond, bar) do { unsigned _sp = 0; while (cond) { __builtin_amdgcn_s_sleep(1); \
    if ((++_sp & 255u) == 0u) { if (xb_ld(&(bar)[XB_TMO])) break; if (_sp > XB_SPIN_CAP) { atomicAdd(&(bar)[XB_TMO], 1u); break; } } } } while (0)
struct XcdBarrier { unsigned* bar; unsigned x; volatile LAS unsigned* st; };
DI XcdBarrier xcd_barrier_post(unsigned* bar, volatile LAS unsigned* st) {
  XcdBarrier b; b.bar = bar; b.x = xb_xcc_id(); b.st = st;
  if (threadIdx.x == 0) (void)xb_add(&bar[XB_XCNT(b.x)], 1u);
  return b;
}
DI XcdBarrier make_xb(const Params& P, char* smem) {
  XcdBarrier b; b.bar = (unsigned*)(P.ws + W_BAR); b.x = xb_xcc_id(); b.st = (volatile LAS unsigned*)(smem + SMEM_BYTES - 16);
  return b;
}
DI void xcd_barrier_complete(unsigned* bar, unsigned x, unsigned& nloc, unsigned& nx) {
  const unsigned G = gridDim.x * gridDim.y * gridDim.z;
  unsigned sum, cnt, mine, sp = 0u;
  for (;;) {
    sum = 0u; cnt = 0u; mine = 0u;
#pragma unroll
    for (unsigned j = 0; j < 16; ++j) { const unsigned c = xb_ld(&bar[XB_XCNT(j)]); sum += c; cnt += (c > 0u) ? 1u : 0u; mine = (j == x) ? c : mine; }
    if (sum == G) break;
    __builtin_amdgcn_s_sleep(1);
    if ((++sp & 255u) == 0u) { if (xb_ld(&bar[XB_TMO])) break; if (sp > XB_SPIN_CAP) { atomicAdd(&bar[XB_TMO], 1u); break; } }
  }
  nloc = mine > 0u ? mine : 1u; nx = cnt > 0u ? cnt : 1u;
}
DI void xcd_barrier(const XcdBarrier& b) {
  asm volatile("s_waitcnt vmcnt(0)" ::: "memory");
  __syncthreads();
  if (threadIdx.x == 0) {
    unsigned* bar = b.bar;
    __builtin_amdgcn_s_waitcnt(0);
    unsigned nloc = b.st[0], nx = b.st[1];
    if (nloc == 0u) { xcd_barrier_complete(bar, b.x, nloc, nx); b.st[0] = nloc; b.st[1] = nx; }
    const unsigned old = xb_add(&bar[XB_XSUB(b.x)], 1u);
    const unsigned gen = old / nloc;
    if (old + 1u == (gen + 1u) * nloc) {
      __builtin_amdgcn_fence(__ATOMIC_RELEASE, "agent");
      asm volatile("s_waitcnt vmcnt(0)" ::: "memory");
      const unsigned og = xb_add(&bar[XB_TOP], 1u);
      const unsigned tg = og / nx;
      if (og + 1u == (tg + 1u) * nx) xb_add(&bar[XB_TOPGEN], 1u);
      else XB_SPIN(xb_ld(&bar[XB_TOPGEN]) == tg, bar);
      __builtin_amdgcn_fence(__ATOMIC_ACQUIRE, "agent");
      xb_add(&bar[XB_XGEN(b.x)], 1u);
      asm volatile("s_waitcnt vmcnt(0)" ::: "memory");
    } else {
      XB_SPIN(xb_ld(&bar[XB_XGEN(b.x)]) == gen, bar);
      __builtin_amdgcn_fence(__ATOMIC_ACQUIRE, "agent");
      asm volatile("s_waitcnt vmcnt(0)" ::: "memory");
    }
  }
  __syncthreads();
}

#ifndef REP0
#define REP0 1
#define REP1 1
#define REP2 1
#define REP3 1
#define REP4 1
#define REP5 1
#define REP6 1
#endif
#define PHASE(body) { body; xcd_barrier(make_xb(P, smem)); }
#define PHASE_R(c, body) for (int r_ = 0; r_ < P.rep[c]; ++r_) { body; xcd_barrier(make_xb(P, smem)); }
template <int L>
DI void run_layer(const Params& P, char* smem) {
  constexpr int l = L, i = L >> 1;
  if ((l & 1) == 0) {
    PHASE_R(2, gemm_phase((const u16*)(P.ws + W_H), (const u16*)(P.ws + W_EIN) + (size_t)i * EIN_PAD * 1024, 19, EpiEvenIn{&P, i}, smem));
    PHASE_R(3, mixer1_phase(P, i, smem));
    PHASE(gla_scan_phase(P, i));
    PHASE_R(3, { for (int item = blockIdx.x; item < 1536; item += gridDim.x) gla_b3_item(P, i, item, smem); });
    PHASE(gemm_phase((const u16*)(P.ws + W_OMIX), (const u16*)(P.ws + W_EOUT) + (size_t)i * 1024 * 1024, 8, EpiOut{&P, l}, smem));
  } else {
    PHASE_R(2, gemm_phase((const u16*)(P.ws + W_H), (const u16*)(P.ws + W_OIN) + (size_t)i * 3072 * 1024, 24, EpiOddIn{&P, i}, smem));
    PHASE_R(4, attnC_phase(P, i, smem));
    PHASE(gemm_phase((const u16*)(P.ws + W_OMIX), (const u16*)(P.ws + W_OOUT) + (size_t)i * 1024 * 1024, 8, EpiOut{&P, l}, smem));
  }
  PHASE_R(1, modnorm_phase(P, l, 1));
  PHASE_R(5, gemm_phase((const u16*)(P.ws + W_H), (const u16*)(P.ws + W_PQ) + (size_t)l * 1024 * 1024, 8, EpiPQ{&P}, smem));
  PHASE_R(6, peer_topk_phase(P, l, smem));
  if (l < 3) { PHASE(peer_expert_phase(P, l)); } else { peer_expert_phase(P, l); }
}

__global__ void __launch_bounds__(256) trunk_megakernel(Params P) {
  cg::grid_group grid = cg::this_grid();
  __shared__ __attribute__((aligned(16))) char smem[SMEM_BYTES];
  if (threadIdx.x == 0) { u32x4 z = {0u, 0u, 0u, 0u}; *(u32x4*)(smem + SMEM_BYTES - 16) = z; }
  __syncthreads();
  (void)xcd_barrier_post((unsigned*)(P.ws + W_BAR), (volatile LAS unsigned*)(smem + SMEM_BYTES - 16));
  prep_phase(P, smem);
  xcd_barrier(make_xb(P, smem));
  if (P.rep[7] == 0x7fffffff) grid.sync();
  PHASE_R(1, modnorm_phase(P, 0, 0));
  run_layer<0>(P, smem);
  run_layer<1>(P, smem);
  run_layer<2>(P, smem);
  run_layer<3>(P, smem);
}
#undef PHASE
#undef PHASE_R

extern "C" void kernel_launch(void* const* d_in, const int* in_sizes, int n_in, void* d_out, int out_size, void* d_ws, size_t ws_size,
                              hipStream_t stream) {
  static int grid_blocks = 0;
  if (!grid_blocks) {
    int dev = 0, cus = 0, per_cu = 0;
    hipGetDevice(&dev);
    hipDeviceGetAttribute(&cus, hipDeviceAttributeMultiprocessorCount, dev);
    hipOccupancyMaxActiveBlocksPerMultiprocessor(&per_cu, trunk_megakernel, 256, 0);
    if (per_cu > 2) per_cu = 2;
    if (per_cu < 1) per_cu = 1;
    grid_blocks = (cus * per_cu) & ~7;
    if (grid_blocks < 8) grid_blocks = 8;
  }
  Params p{};
  for (int k = 0; k < N_IN; ++k) p.in[k] = (const float*)d_in[k];
  p.out = (float*)d_out;
  p.ws = (char*)d_ws;
  p.lam_init[0] = (float)(0.8 - 0.6 * std::exp(-0.3 * 1.0));
  p.lam_init[1] = (float)(0.8 - 0.6 * std::exp(-0.3 * 3.0));
  p.rep[0] = REP0; p.rep[1] = REP1; p.rep[2] = REP2; p.rep[3] = REP3; p.rep[4] = REP4; p.rep[5] = REP5; p.rep[6] = REP6; p.rep[7] = 1;
  hipMemsetAsync((char*)d_ws + W_BAR, 0, XCD_BAR_WORDS * sizeof(unsigned), stream);
  void* args[] = {&p};
  hipError_t e = hipLaunchCooperativeKernel((void*)trunk_megakernel, dim3(grid_blocks), dim3(256), args, 0, stream);
  if (e != hipSuccess) fprintf(stderr, "cooperative launch failed: %s (grid %d)\n", hipGetErrorString(e), grid_blocks);
}
```

```cpp
#include <hip/hip_runtime.h>
#include <hip/hip_cooperative_groups.h>
#include <cmath>
#include <cstdio>
namespace cg = cooperative_groups;

typedef unsigned short u16;
typedef short bf16x8 __attribute__((ext_vector_type(8)));
typedef float f32x16 __attribute__((ext_vector_type(16)));
typedef __bf16 bf16x2_t __attribute__((ext_vector_type(2)));
typedef float f32x2_t __attribute__((ext_vector_type(2)));
typedef unsigned u32x4 __attribute__((ext_vector_type(4)));
typedef unsigned u32x2 __attribute__((ext_vector_type(2)));
typedef float f32x4 __attribute__((ext_vector_type(4)));
#define DI __device__ __forceinline__
#define MFMA(a, b, c) __builtin_amdgcn_mfma_f32_32x32x16_bf16((a), (b), (c), 0, 0, 0)

constexpr int D = 1024;
constexpr int NTOK = 24576;
constexpr int NCTX = 8192;
constexpr int EIN_PAD = 2432;
constexpr float LOG2E = 1.4426950408889634f;
constexpr float QSCALE = 0.125f * LOG2E;
constexpr float EPS = 1e-6f;

enum { I_XP = 0, I_XS, I_CAK, I_CAV, I_SBF, I_SBB, I_CCK, I_CCV, I_C, I_CCTX, I_ADAW, I_ADAB, I_NMG, I_NFG, I_EWIN, I_EWOUT,
       I_AQN, I_AKN, I_ASINK, I_GWF, I_GBF, I_GWB, I_GBB, I_BON, I_OWIN, I_OWOUT, I_CQN, I_CKN, I_LQ1, I_LK1, I_LQ2, I_LK2, I_CON,
       I_PWQ, I_PSK, I_PU, I_PV, N_IN };

constexpr size_t O_X = 0;
constexpr size_t O_CAK = 25165824;
constexpr size_t O_CAV = 27262976;
constexpr size_t O_SBF = 29360128;
constexpr size_t O_SBB = 31457280;
constexpr size_t O_CCK = 33554432;
constexpr size_t O_CCV = 50331648;

constexpr size_t W_EIN = 0;
constexpr size_t W_OIN = W_EIN + 2ull * EIN_PAD * 1024 * 2;
constexpr size_t W_EOUT = W_OIN + 2ull * 3072 * 1024 * 2;
constexpr size_t W_OOUT = W_EOUT + 2ull * 1024 * 1024 * 2;
constexpr size_t W_PQ = W_OOUT + 2ull * 1024 * 1024 * 2;
constexpr size_t W_SK = W_PQ + 4ull * 1024 * 1024 * 2;
constexpr size_t W_PU = W_SK + 4ull * 8 * 2 * 128 * 64 * 2;
constexpr size_t W_PV = W_PU + 4ull * 16384 * 1024 * 2;
constexpr size_t W_MOD = W_PV + 4ull * 16384 * 1024 * 2;
constexpr size_t W_ROPE = W_MOD + 4ull * 5 * 6144 * 4;
constexpr size_t W_LAM = W_ROPE + 64 * 16 * 2 * 4;
constexpr size_t W_H = W_LAM + 256;
constexpr size_t W_Q = W_H + (size_t)NTOK * 1024 * 2;
constexpr size_t W_OMIX = W_Q + (size_t)NTOK * 1024 * 2;
constexpr size_t SZ_KA_DEC = 4ull * 2 * 4608 * 64 * 2;
constexpr size_t W_KA_DEC = W_OMIX + (size_t)NTOK * 1024 * 2;
constexpr size_t W_VAT_DEC = W_KA_DEC + 2 * SZ_KA_DEC;
constexpr size_t W_KA_CTX = W_VAT_DEC + 2 * SZ_KA_DEC;
constexpr size_t W_VAT_CTX = W_KA_CTX + 32ull * 2 * 256 * 64 * 2;
constexpr size_t SZ_KC_DEC = 4ull * 8 * 2 * 4608 * 64 * 2;
constexpr size_t W_KC_DEC = W_VAT_CTX + 32ull * 2 * 256 * 64 * 2;
constexpr size_t W_VCT_DEC = W_KC_DEC + 2 * SZ_KC_DEC;
constexpr size_t W_KC_CTX = W_VCT_DEC + 2 * SZ_KC_DEC;
constexpr size_t W_VCT_CTX = W_KC_CTX + 32ull * 8 * 2 * 256 * 64 * 2;
constexpr size_t W_BQ = W_VCT_CTX + 32ull * 8 * 128 * 256 * 2;
constexpr size_t W_BK = W_BQ + (size_t)NTOK * 256 * 2;
constexpr size_t W_BV = W_BK + (size_t)NTOK * 256 * 2;
constexpr size_t W_BR = W_BV + (size_t)NTOK * 512 * 2;
constexpr size_t W_BG = W_BR + (size_t)NTOK * 512 * 2;
constexpr size_t W_KV = W_BG + (size_t)NTOK * 32 * 4;
constexpr size_t W_DEC = W_KV + 1536ull * 2 * 8192 * 4;
constexpr size_t W_EIDX = W_DEC + 1536ull * 2 * 64 * 4;
constexpr size_t W_EGATE = W_EIDX + (size_t)NTOK * 128 * 4;
constexpr size_t W_PSU = W_EGATE + (size_t)NTOK * 128 * 4;
constexpr size_t W_PSV = W_PSU + 4ull * 16384 * 4;
constexpr size_t W_END = W_PSV + 4ull * 16384 * 4;
constexpr size_t W_BAR = W_END;
static_assert(W_BAR + 16384 < (1ull << 30), "workspace budget");

struct Params {
  const float* in[N_IN];
  float* out;
  char* ws;
  float lam_init[2];
  int rep[8];
};

constexpr int SMEM_BYTES = 256 * 129 * 4 + 512;

DI unsigned pk2(float a, float b) {
  f32x2_t v = {a, b};
  bf16x2_t r = __builtin_convertvector(v, bf16x2_t);
  return __builtin_bit_cast(unsigned, r);
}
DI u16 f2bf(float a) { return (u16)(pk2(a, 0.f) & 0xffffu); }
DI float bf2f(u16 v) { return __uint_as_float(((unsigned)v) << 16); }
DI float bflo(unsigned w) { return __uint_as_float(w << 16); }
DI float bfhi(unsigned w) { return __uint_as_float(w & 0xffff0000u); }
DI int crow(int g, int h) { return (g & 3) + 8 * (g >> 2) + 4 * h; }
DI int pi32(int r) { return (r & ~12) | ((r & 4) << 1) | ((r & 8) >> 1); }
DI bf16x8 ld8(const u16* p) { return __builtin_bit_cast(bf16x8, *(const u32x4*)p); }
DI float wave_sum(float v) {
#pragma unroll
  for (int o = 32; o >= 1; o >>= 1) v += __shfl_xor(v, o);
  return v;
}
DI float silu_f(float x) { return x / (1.f + __expf(-x)); }
DI float dot2bf(unsigned a, unsigned b, float acc) {
  return __builtin_amdgcn_fdot2_f32_bf16(__builtin_bit_cast(bf16x2_t, a), __builtin_bit_cast(bf16x2_t, b), acc, false);
}
DI void tokinfo(int t, int& isdec, int& b, int& s, int& mi) {
  if (t < NCTX) { isdec = 0; b = t >> 8; s = t & 255; mi = 0; }
  else { int u = t - NCTX; isdec = 1; b = u >> 12; s = u & 4095; mi = 1 + b; }
}

DI void transpose_w(const float* __restrict__ src, u16* __restrict__ dst, int N, int Npad) {
  size_t total = (size_t)Npad * 128;
  for (size_t idx = (size_t)blockIdx.x * blockDim.x + threadIdx.x; idx < total; idx += (size_t)gridDim.x * blockDim.x) {
    int n = (int)(idx % Npad), kc = (int)(idx / Npad);
    float v[8];
#pragma unroll
    for (int j = 0; j < 8; ++j) v[j] = (n < N) ? src[(size_t)(kc * 8 + j) * N + n] : 0.f;
    u32x4 o = {pk2(v[0], v[1]), pk2(v[2], v[3]), pk2(v[4], v[5]), pk2(v[6], v[7])};
    *(u32x4*)(dst + (size_t)n * 1024 + kc * 8) = o;
  }
}
DI void convert_bf16(const float* __restrict__ src, u16* __restrict__ dst, size_t n) {
  size_t n8 = n >> 3;
  for (size_t idx = (size_t)blockIdx.x * blockDim.x + threadIdx.x; idx < n8; idx += (size_t)gridDim.x * blockDim.x) {
    f32x4 a = ((const f32x4*)src)[idx * 2], b = ((const f32x4*)src)[idx * 2 + 1];
    u32x4 o = {pk2(a.x, a.y), pk2(a.z, a.w), pk2(b.x, b.y), pk2(b.z, b.w)};
    ((u32x4*)dst)[idx] = o;
  }
}

DI void prep_phase(const Params& P, char* smem) {
  char* ws = P.ws;
  const int tid = threadIdx.x;
  const size_t gtid = (size_t)blockIdx.x * blockDim.x + tid, gsz = (size_t)gridDim.x * blockDim.x;
  {
    float* sS = (float*)smem;
    float* sR = sS + 5 * 1024;
    for (int idx = tid; idx < 5 * 1024; idx += 256) {
      int ci = idx >> 10, k = idx & 1023;
      float c = (ci == 0) ? P.in[I_CCTX][k] : P.in[I_C][(ci - 1) * 1024 + k];
      sS[idx] = silu_f(c);
    }
    __syncthreads();
    float* mod = (float*)(ws + W_MOD);
    for (int item = blockIdx.x; item < 4 * 96; item += gridDim.x) {
      int l = item / 96, ch = item % 96;
      int col = tid & 63, kq = tid >> 6;
      const float* w = P.in[I_ADAW] + (size_t)l * 1024 * 6144 + ch * 64 + col;
      float a0 = 0, a1 = 0, a2 = 0, a3 = 0, a4 = 0;
#pragma unroll 16
      for (int k = kq * 256; k < kq * 256 + 256; ++k) {
        float wv = w[(size_t)k * 6144];
        a0 += sS[k] * wv; a1 += sS[1024 + k] * wv; a2 += sS[2048 + k] * wv; a3 += sS[3072 + k] * wv; a4 += sS[4096 + k] * wv;
      }
      sR[(kq * 5 + 0) * 64 + col] = a0; sR[(kq * 5 + 1) * 64 + col] = a1; sR[(kq * 5 + 2) * 64 + col] = a2;
      sR[(kq * 5 + 3) * 64 + col] = a3; sR[(kq * 5 + 4) * 64 + col] = a4;
      __syncthreads();
      for (int idx = tid; idx < 320; idx += 256) {
        int ci = idx >> 6, c2 = idx & 63;
        float s = sR[(0 * 5 + ci) * 64 + c2] + sR[(1 * 5 + ci) * 64 + c2] + sR[(2 * 5 + ci) * 64 + c2] + sR[(3 * 5 + ci) * 64 + c2];
        mod[((size_t)l * 5 + ci) * 6144 + ch * 64 + c2] = s + P.in[I_ADAB][l * 6144 + ch * 64 + c2];
      }
      __syncthreads();
    }
  }
  for (int i = 0; i < 2; ++i) {
    transpose_w(P.in[I_EWIN] + (size_t)i * 1024 * 2336, (u16*)(ws + W_EIN) + (size_t)i * EIN_PAD * 1024, 2336, EIN_PAD);
    transpose_w(P.in[I_OWIN] + (size_t)i * 1024 * 3072, (u16*)(ws + W_OIN) + (size_t)i * 3072 * 1024, 3072, 3072);
    transpose_w(P.in[I_EWOUT] + (size_t)i * 1024 * 1024, (u16*)(ws + W_EOUT) + (size_t)i * 1024 * 1024, 1024, 1024);
    transpose_w(P.in[I_OWOUT] + (size_t)i * 1024 * 1024, (u16*)(ws + W_OOUT) + (size_t)i * 1024 * 1024, 1024, 1024);
  }
  for (int l = 0; l < 4; ++l)
    transpose_w(P.in[I_PWQ] + (size_t)l * 1024 * 1024, (u16*)(ws + W_PQ) + (size_t)l * 1024 * 1024, 1024, 1024);
  convert_bf16(P.in[I_PSK], (u16*)(ws + W_SK), 4ull * 8 * 2 * 128 * 64);
  {
    const int lane = tid & 63, wv = tid >> 6;
    for (int row0 = (blockIdx.x * 4 + wv) * 4; row0 < 2 * 65536; row0 += gridDim.x * 16) {
      const int which = row0 >> 16, rr0 = row0 & 65535;
      const float* srcp = P.in[which ? I_PV : I_PU] + (size_t)rr0 * 1024 + lane * 16;
      f32x4 a[4][4];
#pragma unroll
      for (int q = 0; q < 4; ++q)
#pragma unroll
        for (int j = 0; j < 4; ++j) a[q][j] = *(const f32x4*)(srcp + (size_t)q * 1024 + j * 4);
#pragma unroll
      for (int q = 0; q < 4; ++q) {
        float m = 0.f;
#pragma unroll
        for (int j = 0; j < 4; ++j) m = fmaxf(m, fmaxf(fmaxf(fabsf(a[q][j].x), fabsf(a[q][j].y)), fmaxf(fabsf(a[q][j].z), fabsf(a[q][j].w))));
#pragma unroll
        for (int o = 32; o >= 1; o >>= 1) m = fmaxf(m, __shfl_xor(m, o));
        const float sc = (m > 0.f) ? m * (1.f / 440.f) : 1.f;
        const float inv = 1.f / sc;
        if (which) {
          const float sc4 = (m > 0.f) ? m * (1.f / 6.f) : 1.f;
          const float inv4 = 1.f / sc4;
          unsigned w0 = 0, w1 = 0;
          w0 = __builtin_amdgcn_cvt_scalef32_pk_fp4_f32(w0, a[q][0].x * inv4, a[q][0].y * inv4, 1.0f, 0);
          w0 = __builtin_amdgcn_cvt_scalef32_pk_fp4_f32(w0, a[q][0].z * inv4, a[q][0].w * inv4, 1.0f, 1);
          w0 = __builtin_amdgcn_cvt_scalef32_pk_fp4_f32(w0, a[q][1].x * inv4, a[q][1].y * inv4, 1.0f, 2);
          w0 = __builtin_amdgcn_cvt_scalef32_pk_fp4_f32(w0, a[q][1].z * inv4, a[q][1].w * inv4, 1.0f, 3);
          w1 = __builtin_amdgcn_cvt_scalef32_pk_fp4_f32(w1, a[q][2].x * inv4, a[q][2].y * inv4, 1.0f, 0);
          w1 = __builtin_amdgcn_cvt_scalef32_pk_fp4_f32(w1, a[q][2].z * inv4, a[q][2].w * inv4, 1.0f, 1);
          w1 = __builtin_amdgcn_cvt_scalef32_pk_fp4_f32(w1, a[q][3].x * inv4, a[q][3].y * inv4, 1.0f, 2);
          w1 = __builtin_amdgcn_cvt_scalef32_pk_fp4_f32(w1, a[q][3].z * inv4, a[q][3].w * inv4, 1.0f, 3);
          u32x2 o = {w0, w1};
          *(u32x2*)(ws + W_PU + (size_t)(rr0 + q) * 1536 + 1024 + lane * 8) = o;
          if (lane == 0) ((float*)(ws + W_PSV))[rr0 + q] = sc4;
        } else {
          unsigned w[4];
#pragma unroll
          for (int j = 0; j < 4; ++j) {
            int t = __builtin_amdgcn_cvt_pk_fp8_f32(a[q][j].x * inv, a[q][j].y * inv, 0, false);
            t = __builtin_amdgcn_cvt_pk_fp8_f32(a[q][j].z * inv, a[q][j].w * inv, t, true);
            w[j] = (unsigned)t;
          }
          u32x4 o = {w[0], w[1], w[2], w[3]};
          *(u32x4*)(ws + W_PU + (size_t)(rr0 + q) * 1536 + lane * 16) = o;
          if (lane == 0) ((float*)(ws + W_PSU))[rr0 + q] = sc;
        }
      }
    }
  }
  {
    size_t n = 4ull * 2 * 512 * 2 * 64;
    for (size_t idx = gtid; idx < n; idx += gsz) {
      int d = idx & 63, kv = (idx >> 6) & 1, s = (idx >> 7) & 511, i = (idx >> 16) & 1, b = (int)(idx >> 17);
      float kvv = P.in[I_CAK][idx], vv = P.in[I_CAV][idx];
      u16* ka = (u16*)(ws + W_KA_DEC + i * SZ_KA_DEC);
      u16* va = (u16*)(ws + W_VAT_DEC + i * SZ_KA_DEC);
      ka[((size_t)(b * 2 + kv) * 4608 + 4096 + s) * 64 + d] = f2bf(kvv);
      va[((size_t)(b * 2 + kv) * 64 + d) * 4608 + 4096 + s] = f2bf(vv);
    }
    n = 4ull * 2 * 512 * 8 * 2 * 64;
    for (size_t idx = gtid; idx < n; idx += gsz) {
      int d = idx & 63, m = (idx >> 6) & 1, hd = (idx >> 7) & 7, s = (idx >> 10) & 511, i = (idx >> 19) & 1, b = (int)(idx >> 20);
      u16* kc = (u16*)(ws + W_KC_DEC + i * SZ_KC_DEC);
      kc[(((size_t)(b * 8 + hd) * 2 + m) * 4608 + 4096 + s) * 64 + d] = f2bf(P.in[I_CCK][idx]);
    }
    for (size_t idx = gtid; idx < n; idx += gsz) {
      int dv = idx & 127, hd = (idx >> 7) & 7, s = (idx >> 10) & 511, i = (idx >> 19) & 1, b = (int)(idx >> 20);
      u16* vc = (u16*)(ws + W_VCT_DEC + i * SZ_KC_DEC);
      vc[((size_t)(b * 8 + hd) * 128 + dv) * 4608 + 4096 + s] = f2bf(P.in[I_CCV][idx]);
    }
  }
  if (blockIdx.x == 0) {
    float* rt = (float*)(ws + W_ROPE);
    for (int idx = tid; idx < 64 * 16; idx += 256) {
      int p = idx >> 4, f = idx & 15;
      float freq = powf(10000.0f, -(float)f / 16.0f);
      float ang = (float)p * freq;
      rt[idx * 2] = cosf(ang); rt[idx * 2 + 1] = sinf(ang);
    }
    if (tid < 2) {
      float s1 = 0, s2 = 0;
      for (int k = 0; k < 64; ++k) {
        s1 += P.in[I_LQ1][tid * 64 + k] * P.in[I_LK1][tid * 64 + k];
        s2 += P.in[I_LQ2][tid * 64 + k] * P.in[I_LK2][tid * 64 + k];
      }
      ((float*)(ws + W_LAM))[tid] = expf(s1) - expf(s2) + P.lam_init[tid];
      float ga = 0, gk = 0, gc = 0, gck = 0;
      for (int k = 0; k < 64; ++k) {
        ga = fmaxf(ga, fabsf(P.in[I_AQN][tid * 64 + k])); gk = fmaxf(gk, fabsf(P.in[I_AKN][tid * 64 + k]));
        gc = fmaxf(gc, fabsf(P.in[I_CQN][tid * 64 + k])); gck = fmaxf(gck, fabsf(P.in[I_CKN][tid * 64 + k]));
      }
      float ma = 64.f * ga * gk * QSCALE * 1.03f + 0.01f;
      for (int k = 0; k < 8; ++k) ma = fmaxf(ma, P.in[I_ASINK][tid * 8 + k] * LOG2E);
      ((float*)(ws + W_LAM))[2 + tid] = ma;
      ((float*)(ws + W_LAM))[4 + tid] = 64.f * gc * gck * QSCALE * 1.03f + 0.01f;
    }
  }
}

DI void modnorm_row_write(const Params& P, int l, int which, int t, int lane, const float (&xv)[16]) {
  int isdec, b, s, mi; tokinfo(t, isdec, b, s, mi);
  float ss = 0;
#pragma unroll
  for (int j = 0; j < 16; ++j) ss += xv[j] * xv[j];
  ss = wave_sum(ss);
  float rstd = rsqrtf(ss * (1.f / 1024.f) + EPS);
  const float* g = P.in[which ? I_NFG : I_NMG] + l * 1024;
  const float* mod = (const float*)(P.ws + W_MOD) + ((size_t)l * 5 + mi) * 6144;
  const float* sc = mod + (which ? 4 : 1) * 1024;
  const float* sh = mod + (which ? 3 : 0) * 1024;
  u16* h = (u16*)(P.ws + W_H) + (size_t)t * 1024;
#pragma unroll
  for (int j = 0; j < 4; ++j) {
    int c = j * 256 + lane * 4;
    f32x4 gv = *(const f32x4*)(g + c), scv = *(const f32x4*)(sc + c), shv = *(const f32x4*)(sh + c);
    float o0 = xv[j * 4 + 0] * rstd * gv.x * (1.f + scv.x) + shv.x;
    float o1 = xv[j * 4 + 1] * rstd * gv.y * (1.f + scv.y) + shv.y;
    float o2 = xv[j * 4 + 2] * rstd * gv.z * (1.f + scv.z) + shv.z;
    float o3 = xv[j * 4 + 3] * rstd * gv.w * (1.f + scv.w) + shv.w;
    u32x2 o = {pk2(o0, o1), pk2(o2, o3)};
    *(u32x2*)(h + c) = o;
  }
}
DI void modnorm_phase(const Params& P, int l, int which) {
  const int lane = threadIdx.x & 63, wave = threadIdx.x >> 6;
  const bool from_in = (l == 0 && which == 0);
  const int stride = gridDim.x * 4;
  for (int t = blockIdx.x * 4 + wave; t < NTOK; t += 2 * stride) {
    const int t2 = t + stride;
    const bool has2 = t2 < NTOK;
    const int t2c = has2 ? t2 : t;
    const float* xrow = from_in ? ((t < NCTX) ? P.in[I_XP] + (size_t)t * 1024 : P.in[I_XS] + (size_t)(t - NCTX) * 1024) : P.out + O_X + (size_t)t * 1024;
    const float* xrow2 = from_in ? ((t2c < NCTX) ? P.in[I_XP] + (size_t)t2c * 1024 : P.in[I_XS] + (size_t)(t2c - NCTX) * 1024) : P.out + O_X + (size_t)t2c * 1024;
    float xv[16], xw[16];
#pragma unroll
    for (int j = 0; j < 4; ++j) {
      f32x4 v = *(const f32x4*)(xrow + j * 256 + lane * 4);
      f32x4 w = *(const f32x4*)(xrow2 + j * 256 + lane * 4);
      xv[j * 4] = v.x; xv[j * 4 + 1] = v.y; xv[j * 4 + 2] = v.z; xv[j * 4 + 3] = v.w;
      xw[j * 4] = w.x; xw[j * 4 + 1] = w.y; xw[j * 4 + 2] = w.z; xw[j * 4 + 3] = w.w;
    }
    modnorm_row_write(P, l, which, t, lane, xv);
    if (has2) modnorm_row_write(P, l, which, t2, lane, xw);
  }
}

template <class Epi>
DI void gemm_phase(const u16* __restrict__ A, const u16* __restrict__ Wt, int n_tiles, Epi epi, char* smem) {
  constexpr int BK = 64, LDK = 72, NKT = 1024 / BK;
  constexpr int A_ELEMS = 256 * LDK, B_ELEMS = 128 * LDK, STAGE = A_ELEMS + B_ELEMS;
  const int tid = threadIdx.x, lane = tid & 63, wave = tid >> 6;
  const int wm = wave >> 1, wn = wave & 1, r = lane & 31, h = lane >> 5;
  u16* sbase = (u16*)smem;
  float* sC = (float*)smem;
  const int crw = tid >> 3, ckc = (tid & 7) * 8;
  const int xcd = blockIdx.x & 7, nloc = gridDim.x >> 3;
  for (int q = blockIdx.x >> 3; q < 12 * n_tiles; q += nloc) {
    const int mt = xcd * 12 + q / n_tiles, nt = q % n_tiles;
    const u16* Ab = A + (size_t)mt * 256 * 1024 + (size_t)crw * 1024 + ckc;
    const u16* Bb = Wt + (size_t)nt * 128 * 1024 + (size_t)crw * 1024 + ckc;
    f32x16 acc[4][2];
#pragma unroll
    for (int i = 0; i < 4; ++i)
#pragma unroll
      for (int j = 0; j < 2; ++j)
#pragma unroll
        for (int g = 0; g < 16; ++g) acc[i][j][g] = 0.f;
    u32x4 ra[8], rb[4];
#pragma unroll
    for (int j = 0; j < 8; ++j) ra[j] = *(const u32x4*)(Ab + (size_t)j * 32 * 1024);
#pragma unroll
    for (int j = 0; j < 4; ++j) rb[j] = *(const u32x4*)(Bb + (size_t)j * 32 * 1024);
#pragma unroll
    for (int j = 0; j < 8; ++j) *(u32x4*)(sbase + (crw + 32 * j) * LDK + ckc) = ra[j];
#pragma unroll
    for (int j = 0; j < 4; ++j) *(u32x4*)(sbase + A_ELEMS + (crw + 32 * j) * LDK + ckc) = rb[j];
#pragma unroll
    for (int j = 0; j < 8; ++j) ra[j] = *(const u32x4*)(Ab + (size_t)j * 32 * 1024 + BK);
#pragma unroll
    for (int j = 0; j < 4; ++j) rb[j] = *(const u32x4*)(Bb + (size_t)j * 32 * 1024 + BK);
    __syncthreads();
    for (int kt = 0; kt < NKT; ++kt) {
      const u16* sA = sbase + (kt & 1) * STAGE;
      const u16* sB = sA + A_ELEMS;
      u16* sAn = sbase + ((kt & 1) ^ 1) * STAGE;
      u16* sBn = sAn + A_ELEMS;
#pragma unroll
      for (int ks = 0; ks < 4; ++ks) {
        bf16x8 a[4], b[2];
#pragma unroll
        for (int i = 0; i < 4; ++i) a[i] = ld8(sA + (wm * 128 + i * 32 + r) * LDK + ks * 16 + h * 8);
#pragma unroll
        for (int j = 0; j < 2; ++j) b[j] = ld8(sB + (wn * 64 + j * 32 + r) * LDK + ks * 16 + h * 8);
#pragma unroll
        for (int i = 0; i < 4; ++i)
#pragma unroll
          for (int j = 0; j < 2; ++j) acc[i][j] = MFMA(a[i], b[j], acc[i][j]);
        if (ks == 0 && kt + 1 < NKT) {
#pragma unroll
          for (int j = 0; j < 8; ++j) *(u32x4*)(sAn + (crw + 32 * j) * LDK + ckc) = ra[j];
#pragma unroll
          for (int j = 0; j < 4; ++j) *(u32x4*)(sBn + (crw + 32 * j) * LDK + ckc) = rb[j];
          if (kt + 2 < NKT) {
#pragma unroll
            for (int j = 0; j < 8; ++j) ra[j] = *(const u32x4*)(Ab + (size_t)j * 32 * 1024 + (kt + 2) * BK);
#pragma unroll
            for (int j = 0; j < 4; ++j) rb[j] = *(const u32x4*)(Bb + (size_t)j * 32 * 1024 + (kt + 2) * BK);
          }
        }
      }
      __syncthreads();
    }
#pragma unroll
    for (int i = 0; i < 4; ++i)
#pragma unroll
      for (int j = 0; j < 2; ++j)
#pragma unroll
        for (int g = 0; g < 16; ++g)
          sC[(wm * 128 + i * 32 + crow(g, h)) * 129 + wn * 64 + j * 32 + r] = acc[i][j][g];
    __syncthreads();
    epi(mt * 2, nt, sC);
    epi(mt * 2 + 1, nt, sC + 128 * 129);
    __syncthreads();
  }
}

DI void load32(const float* sC, int base, float (&v)[32]) {
#pragma unroll
  for (int j = 0; j < 32; ++j) v[j] = sC[base + j];
}
DI void headnorm_rope32(float (&v)[32], int a, const float* __restrict__ gain, bool rope, int s, const float* __restrict__ rt, float scale) {
  float ss = 0;
#pragma unroll
  for (int d = 0; d < 32; ++d) ss += v[d] * v[d];
  ss += __shfl_xor(ss, 1);
  float rstd = rsqrtf(ss * (1.f / 64.f) + EPS);
#pragma unroll
  for (int d = 0; d < 32; ++d) v[d] = v[d] * rstd * gain[a * 32 + d];
  if (rope) {
    const float* tb = rt + (a == 0 ? (s >> 6) : (s & 63)) * 32;
#pragma unroll
    for (int f = 0; f < 16; ++f) {
      float cs = tb[f * 2], sn = tb[f * 2 + 1];
      float x1 = v[f], x2 = v[16 + f];
      v[f] = x1 * cs - x2 * sn;
      v[16 + f] = x2 * cs + x1 * sn;
    }
  }
#pragma unroll
  for (int d = 0; d < 32; ++d) v[d] *= scale;
}
DI void store32_bf16(u16* dst, const float (&v)[32]) {
#pragma unroll
  for (int j = 0; j < 4; ++j) {
    u32x4 o = {pk2(v[j * 8], v[j * 8 + 1]), pk2(v[j * 8 + 2], v[j * 8 + 3]), pk2(v[j * 8 + 4], v[j * 8 + 5]), pk2(v[j * 8 + 6], v[j * 8 + 7])};
    *(u32x4*)(dst + j * 8) = o;
  }
}
DI void store32_f32(float* dst, const float (&v)[32]) {
#pragma unroll
  for (int j = 0; j < 8; ++j) {
    f32x4 o = {v[j * 4], v[j * 4 + 1], v[j * 4 + 2], v[j * 4 + 3]};
    *(f32x4*)(dst + j * 4) = o;
  }
}

struct EpiEvenIn {
  const Params* P; int i;
  DI void operator()(int mt, int nt, const float* sC) const {
    const Params& p = *P; char* ws = p.ws;
    const int tid = threadIdx.x;
    const int t0 = mt * 128;
    int isdec, b, s0, mi; tokinfo(t0, isdec, b, s0, mi);
    const float* rt = (const float*)(ws + W_ROPE);
    if (nt == 5) {
      const int c = tid & 127, tg = tid >> 7, kv = c >> 6, d = c & 63;
#pragma unroll 1
      for (int q = 0; q < 2; ++q) {
        const int tk = (q * 2 + tg) * 32;
        float v[32];
#pragma unroll
        for (int j = 0; j < 32; ++j) v[j] = sC[(tk + j) * 129 + c];
        const int s = s0 + tk;
        if (isdec) {
          store32_bf16((u16*)(ws + W_VAT_DEC + i * SZ_KA_DEC) + ((size_t)(b * 2 + kv) * 64 + d) * 4608 + s, v);
        } else {
          store32_bf16((u16*)(ws + W_VAT_CTX) + ((size_t)(b * 2 + kv) * 64 + d) * 256 + s, v);
          float* o = p.out + O_CAV + ((((size_t)b * 2 + i) * 256 + s) * 2 + kv) * 64 + d;
#pragma unroll
          for (int j = 0; j < 32; ++j) o[(size_t)j * 128] = v[j];
        }
      }
      return;
    }
    const int row = tid >> 1, a = tid & 1;
    const int t = t0 + row, s = s0 + row;
#pragma unroll 1
    for (int seg = 0; seg < 2; ++seg) {
      if (nt == 18 && seg == 1) break;
      float v[32];
      load32(sC, row * 129 + seg * 64 + a * 32, v);
      if (nt < 4) {
        int head = nt * 2 + seg;
        headnorm_rope32(v, a, p.in[I_AQN] + i * 64, isdec, s, rt, QSCALE);
        store32_bf16((u16*)(ws + W_Q) + (size_t)t * 1024 + head * 64 + a * 32, v);
      } else if (nt == 4) {
        int kv = seg;
        headnorm_rope32(v, a, p.in[I_AKN] + i * 64, isdec, s, rt, 1.f);
        if (isdec) {
          store32_bf16((u16*)(ws + W_KA_DEC + i * SZ_KA_DEC) + ((size_t)(b * 2 + kv) * 4608 + s) * 64 + a * 32, v);
        } else {
          store32_bf16((u16*)(ws + W_KA_CTX) + ((size_t)(b * 2 + kv) * 256 + s) * 64 + a * 32, v);
          store32_f32(p.out + O_CAK + ((((size_t)b * 2 + i) * 256 + s) * 2 + kv) * 64 + a * 32, v);
        }
      } else if (nt < 8) {
#pragma unroll
        for (int j = 0; j < 32; ++j) v[j] *= 0.125f;
        store32_bf16((u16*)(ws + W_BQ) + (size_t)t * 256 + (nt - 6) * 128 + seg * 64 + a * 32, v);
      } else if (nt < 10) {
        store32_bf16((u16*)(ws + W_BK) + (size_t)t * 256 + (nt - 8) * 128 + seg * 64 + a * 32, v);
      } else if (nt < 14) {
        store32_bf16((u16*)(ws + W_BV) + (size_t)t * 512 + (nt - 10) * 128 + seg * 64 + a * 32, v);
      } else if (nt < 18) {
        store32_bf16((u16*)(ws + W_BR) + (size_t)t * 512 + (nt - 14) * 128 + seg * 64 + a * 32, v);
      } else {
        if (a == 0) store32_f32((float*)(ws + W_BG) + (size_t)t * 32, v);
      }
    }
  }
};

struct EpiOddIn {
  const Params* P; int i;
  DI void operator()(int mt, int nt, const float* sC) const {
    const Params& p = *P; char* ws = p.ws;
    const int tid = threadIdx.x;
    const int t0 = mt * 128;
    int isdec, b, s0, mi; tokinfo(t0, isdec, b, s0, mi);
    const float* rt = (const float*)(ws + W_ROPE);
    if (nt >= 16) {
      const int c = tid & 127, tg = tid >> 7, hd = nt - 16;
#pragma unroll 1
      for (int q = 0; q < 2; ++q) {
        const int tk = (q * 2 + tg) * 32;
        float v[32];
#pragma unroll
        for (int j = 0; j < 32; ++j) v[j] = sC[(tk + j) * 129 + c];
        const int s = s0 + tk;
        if (isdec) {
          store32_bf16((u16*)(ws + W_VCT_DEC + i * SZ_KC_DEC) + ((size_t)(b * 8 + hd) * 128 + c) * 4608 + s, v);
        } else {
          store32_bf16((u16*)(ws + W_VCT_CTX) + ((size_t)(b * 8 + hd) * 128 + c) * 256 + s, v);
          float* o = p.out + O_CCV + ((((size_t)b * 2 + i) * 256 + s) * 8 + hd) * 128 + c;
#pragma unroll
          for (int j = 0; j < 32; ++j) o[(size_t)j * 1024] = v[j];
        }
      }
      return;
    }
    const int row = tid >> 1, a = tid & 1;
    const int t = t0 + row, s = s0 + row;
#pragma unroll 1
    for (int seg = 0; seg < 2; ++seg) {
      float v[32];
      load32(sC, row * 129 + seg * 64 + a * 32, v);
      if (nt < 8) {
        headnorm_rope32(v, a, p.in[I_CQN] + i * 64, isdec, s, rt, QSCALE);
        store32_bf16((u16*)(ws + W_Q) + (size_t)t * 1024 + nt * 128 + seg * 64 + a * 32, v);
      } else {
        int hd = nt - 8, m = seg;
        headnorm_rope32(v, a, p.in[I_CKN] + i * 64, isdec, s, rt, 1.f);
        if (isdec) {
          store32_bf16((u16*)(ws + W_KC_DEC + i * SZ_KC_DEC) + (((size_t)(b * 8 + hd) * 2 + m) * 4608 + s) * 64 + a * 32, v);
        } else {
          store32_bf16((u16*)(ws + W_KC_CTX) + (((size_t)(b * 8 + hd) * 2 + m) * 256 + s) * 64 + a * 32, v);
          store32_f32(p.out + O_CCK + (((((size_t)b * 2 + i) * 256 + s) * 8 + hd) * 2 + m) * 64 + a * 32, v);
        }
      }
    }
  }
};

struct EpiOut {
  const Params* P; int l;
  DI void operator()(int mt, int nt, const float* sC) const {
    const Params& p = *P;
    const int tid = threadIdx.x;
    const int t0 = mt * 128;
    int isdec, b, s0, mi; tokinfo(t0, isdec, b, s0, mi);
    const int c = (tid & 31) * 4;
    const float* g1 = (const float*)(p.ws + W_MOD) + ((size_t)l * 5 + mi) * 6144 + 2 * 1024 + nt * 128 + c;
    f32x4 gv = *(const f32x4*)g1;
    float* x = p.out + O_X;
    const float* xin = (l != 0) ? (const float*)x : ((t0 < NCTX) ? p.in[I_XP] : p.in[I_XS] - (size_t)NCTX * 1024);
#pragma unroll
    for (int j = 0; j < 16; ++j) {
      int row = (tid >> 5) + 8 * j;
      f32x4* xp = (f32x4*)(x + (size_t)(t0 + row) * 1024 + nt * 128 + c);
      f32x4 xv = *(const f32x4*)(xin + (size_t)(t0 + row) * 1024 + nt * 128 + c);
      const float* cc = sC + row * 129 + c;
      xv.x += gv.x * cc[0]; xv.y += gv.y * cc[1]; xv.z += gv.z * cc[2]; xv.w += gv.w * cc[3];
      *xp = xv;
    }
  }
};

struct EpiPQ {
  const Params* P;
  DI void operator()(int mt, int nt, const float* sC) const {
    const int tid = threadIdx.x;
    const int c = (tid & 31) * 4;
    u16* q = (u16*)(P->ws + W_Q);
#pragma unroll
    for (int j = 0; j < 16; ++j) {
      int row = (tid >> 5) + 8 * j;
      const float* cc = sC + row * 129 + c;
      u32x2 o = {pk2(cc[0], cc[1]), pk2(cc[2], cc[3])};
      *(u32x2*)(q + (size_t)(mt * 128 + row) * 1024 + nt * 128 + c) = o;
    }
  }
};

template <int DV, bool DIFF, int QG>
DI void attn_item(const u16* __restrict__ Qb  , const u16* __restrict__ Kb, size_t kmap_stride,
                  const u16* __restrict__ VT, int vt_stride, int ta0, int ta1, int tb0, int tb1, bool window, int qpos0,
                  float Mb, float sinkp, float lam, const float* __restrict__ onorm, float oscale,
                  u16* __restrict__ Ob  , char* smem) {
  constexpr int RB = DV / 32;
  constexpr int KMAPS = DIFF ? 2 : 1;
  constexpr int KBUF = KMAPS * 64 * 72, VBUF = DV * 72;
  const int tid = threadIdx.x, lane = tid & 63, wave = tid >> 6, r = lane & 31, h = lane >> 5;
  const int mw = DIFF ? (wave >> 1) : 0;
  const int qrow0 = DIFF ? ((wave & 1) * QG * 32 + r) : (wave * QG * 32 + r);
  u16* sK = (u16*)smem;
  u16* sV = sK + 2 * KBUF;
  const int c0 = tid, c1 = tid + 256, c2 = tid + 512, c3 = tid + 768;
  bf16x8 qf[QG][4];
#pragma unroll
  for (int qg = 0; qg < QG; ++qg)
#pragma unroll
    for (int ks = 0; ks < 4; ++ks) qf[qg][ks] = ld8(Qb + (size_t)(qrow0 + qg * 32) * 1024 + mw * 64 + ks * 16 + h * 8);
  f32x16 acc[QG][RB];
  float lrun[QG];
#pragma unroll
  for (int qg = 0; qg < QG; ++qg) {
#pragma unroll
    for (int rb = 0; rb < RB; ++rb)
#pragma unroll
      for (int g = 0; g < 16; ++g) acc[qg][rb][g] = 0.f;
    lrun[qg] = (h == 0) ? sinkp : 0.f;
  }
  const int na = ta1 - ta0, ntl = na + (tb1 - tb0);
  u32x4 st0, st1, st2, st3;
  {
    const int tile = (0 < na) ? ta0 : tb0;
    const u16* kp = Kb + (size_t)tile * 64 * 64;
    st0 = *(const u32x4*)(kp + (size_t)(c0 >> 3) * 64 + (c0 & 7) * 8);
    st1 = *(const u32x4*)(kp + (size_t)(c1 >> 3) * 64 + (c1 & 7) * 8);
    if (KMAPS > 1) {
      st2 = *(const u32x4*)(kp + kmap_stride + (size_t)(c0 >> 3) * 64 + (c0 & 7) * 8);
      st3 = *(const u32x4*)(kp + kmap_stride + (size_t)(c1 >> 3) * 64 + (c1 & 7) * 8);
    }
    *(u32x4*)(sK + (c0 >> 3) * 72 + (c0 & 7) * 8) = st0;
    *(u32x4*)(sK + (c1 >> 3) * 72 + (c1 & 7) * 8) = st1;
    if (KMAPS > 1) {
      *(u32x4*)(sK + 64 * 72 + (c0 >> 3) * 72 + (c0 & 7) * 8) = st2;
      *(u32x4*)(sK + 64 * 72 + (c1 >> 3) * 72 + (c1 & 7) * 8) = st3;
    }
    const u16* vp = VT + (size_t)tile * 64;
    st0 = *(const u32x4*)(vp + (size_t)(c0 >> 3) * vt_stride + (c0 & 7) * 8);
    st1 = *(const u32x4*)(vp + (size_t)(c1 >> 3) * vt_stride + (c1 & 7) * 8);
    if (DV > 64) {
      st2 = *(const u32x4*)(vp + (size_t)(c2 >> 3) * vt_stride + (c2 & 7) * 8);
      st3 = *(const u32x4*)(vp + (size_t)(c3 >> 3) * vt_stride + (c3 & 7) * 8);
    }
    *(u32x4*)(sV + (c0 >> 3) * 72 + (c0 & 7) * 8) = st0;
    *(u32x4*)(sV + (c1 >> 3) * 72 + (c1 & 7) * 8) = st1;
    if (DV > 64) {
      *(u32x4*)(sV + (c2 >> 3) * 72 + (c2 & 7) * 8) = st2;
      *(u32x4*)(sV + (c3 >> 3) * 72 + (c3 & 7) * 8) = st3;
    }
  }
  for (int it = 0; it < ntl; ++it) {
    const int tile = (it < na) ? (ta0 + it) : (tb0 + it - na);
    const int cur = it & 1, nxt = cur ^ 1;
    const bool more = (it + 1 < ntl);
    const int ntile = (it + 1 < na) ? (ta0 + it + 1) : (tb0 + it + 1 - na);
    const u16* sKc = sK + cur * KBUF + mw * 64 * 72;
    const u16* sVc = sV + cur * VBUF;
    __syncthreads();
    if (more) {
      const u16* kp = Kb + (size_t)ntile * 64 * 64;
      st0 = *(const u32x4*)(kp + (size_t)(c0 >> 3) * 64 + (c0 & 7) * 8);
      st1 = *(const u32x4*)(kp + (size_t)(c1 >> 3) * 64 + (c1 & 7) * 8);
      if (KMAPS > 1) {
        st2 = *(const u32x4*)(kp + kmap_stride + (size_t)(c0 >> 3) * 64 + (c0 & 7) * 8);
        st3 = *(const u32x4*)(kp + kmap_stride + (size_t)(c1 >> 3) * 64 + (c1 & 7) * 8);
      }
    }
    const bool domask = window && (it < na);
    f32x16 s[QG][2];
#pragma unroll
    for (int kb = 0; kb < 2; ++kb) {
#pragma unroll
      for (int qg = 0; qg < QG; ++qg)
#pragma unroll
        for (int g = 0; g < 16; ++g) s[qg][kb][g] = -Mb;
#pragma unroll
      for (int ks = 0; ks < 4; ++ks) {
        bf16x8 a = ld8(sKc + (kb * 32 + pi32(r)) * 72 + ks * 16 + h * 8);
#pragma unroll
        for (int qg = 0; qg < QG; ++qg) s[qg][kb] = MFMA(a, qf[qg][ks], s[qg][kb]);
      }
    }
    bf16x8 pf[QG][2][2];
#pragma unroll
    for (int qg = 0; qg < QG; ++qg) {
      if (domask) {
        const int qpos = qpos0 + qrow0 + qg * 32;
#pragma unroll
        for (int kb = 0; kb < 2; ++kb)
#pragma unroll
          for (int g = 0; g < 16; ++g) {
            int kpos = tile * 64 + kb * 32 + 16 * (g >> 3) + 8 * h + (g & 7);
            int dlt = qpos - kpos;
            if (dlt > 128 || dlt < -128) s[qg][kb][g] = -INFINITY;
          }
      }
      float ls = 0.f;
#pragma unroll
      for (int kb = 0; kb < 2; ++kb)
#pragma unroll
        for (int g = 0; g < 16; ++g) { float pv = __builtin_amdgcn_exp2f(s[qg][kb][g]); s[qg][kb][g] = pv; ls += pv; }
      lrun[qg] += ls;
#pragma unroll
      for (int kb = 0; kb < 2; ++kb)
#pragma unroll
        for (int s2 = 0; s2 < 2; ++s2) {
          u32x4 u = {pk2(s[qg][kb][8 * s2], s[qg][kb][8 * s2 + 1]), pk2(s[qg][kb][8 * s2 + 2], s[qg][kb][8 * s2 + 3]),
                     pk2(s[qg][kb][8 * s2 + 4], s[qg][kb][8 * s2 + 5]), pk2(s[qg][kb][8 * s2 + 6], s[qg][kb][8 * s2 + 7])};
          pf[qg][kb][s2] = __builtin_bit_cast(bf16x8, u);
        }
    }
    if (more) {
      u16* sKn = sK + nxt * KBUF;
      *(u32x4*)(sKn + (c0 >> 3) * 72 + (c0 & 7) * 8) = st0;
      *(u32x4*)(sKn + (c1 >> 3) * 72 + (c1 & 7) * 8) = st1;
      if (KMAPS > 1) {
        *(u32x4*)(sKn + 64 * 72 + (c0 >> 3) * 72 + (c0 & 7) * 8) = st2;
        *(u32x4*)(sKn + 64 * 72 + (c1 >> 3) * 72 + (c1 & 7) * 8) = st3;
      }
      const u16* vp = VT + (size_t)ntile * 64;
      st0 = *(const u32x4*)(vp + (size_t)(c0 >> 3) * vt_stride + (c0 & 7) * 8);
      st1 = *(const u32x4*)(vp + (size_t)(c1 >> 3) * vt_stride + (c1 & 7) * 8);
      if (DV > 64) {
        st2 = *(const u32x4*)(vp + (size_t)(c2 >> 3) * vt_stride + (c2 & 7) * 8);
        st3 = *(const u32x4*)(vp + (size_t)(c3 >> 3) * vt_stride + (c3 & 7) * 8);
      }
    }
#pragma unroll
    for (int rb = 0; rb < RB; ++rb)
#pragma unroll
      for (int kb = 0; kb < 2; ++kb)
#pragma unroll
        for (int s2 = 0; s2 < 2; ++s2) {
          bf16x8 v = ld8(sVc + (rb * 32 + r) * 72 + kb * 32 + s2 * 16 + h * 8);
#pragma unroll
          for (int qg = 0; qg < QG; ++qg) acc[qg][rb] = MFMA(v, pf[qg][kb][s2], acc[qg][rb]);
        }
    if (more) {
      u16* sVn = sV + nxt * VBUF;
      *(u32x4*)(sVn + (c0 >> 3) * 72 + (c0 & 7) * 8) = st0;
      *(u32x4*)(sVn + (c1 >> 3) * 72 + (c1 & 7) * 8) = st1;
      if (DV > 64) {
        *(u32x4*)(sVn + (c2 >> 3) * 72 + (c2 & 7) * 8) = st2;
        *(u32x4*)(sVn + (c3 >> 3) * 72 + (c3 & 7) * 8) = st3;
      }
    }
  }
  float inv[QG];
#pragma unroll
  for (int qg = 0; qg < QG; ++qg) { const float lt = lrun[qg] + __shfl_xor(lrun[qg], 32); inv[qg] = 1.f / lt; }
  if (!DIFF) {
#pragma unroll
    for (int qg = 0; qg < QG; ++qg) {
      u16* orow = Ob + (size_t)(qrow0 + qg * 32) * 1024;
#pragma unroll
      for (int rb = 0; rb < RB; ++rb)
#pragma unroll
        for (int g4 = 0; g4 < 4; ++g4) {
          u32x2 o = {pk2(acc[qg][rb][g4 * 4] * inv[qg], acc[qg][rb][g4 * 4 + 1] * inv[qg]),
                     pk2(acc[qg][rb][g4 * 4 + 2] * inv[qg], acc[qg][rb][g4 * 4 + 3] * inv[qg])};
          *(u32x2*)(orow + rb * 32 + 8 * g4 + 4 * h) = o;
        }
    }
    __syncthreads();
  } else {
    float* sX = (float*)smem;
    __syncthreads();
    if (mw == 1) {
#pragma unroll
      for (int qg = 0; qg < QG; ++qg) {
        const float c1f = lam * inv[qg];
#pragma unroll
        for (int rb = 0; rb < RB; ++rb)
#pragma unroll
          for (int g = 0; g < 16; ++g) sX[((((wave & 1) * QG + qg) * RB + rb) * 16 + g) * 64 + lane] = acc[qg][rb][g] * c1f;
      }
    }
    __syncthreads();
    if (mw == 0) {
#pragma unroll
      for (int qg = 0; qg < QG; ++qg) {
        float ss = 0.f;
#pragma unroll
        for (int rb = 0; rb < RB; ++rb)
#pragma unroll
          for (int g = 0; g < 16; ++g) {
            float o = acc[qg][rb][g] * inv[qg] - sX[((((wave & 1) * QG + qg) * RB + rb) * 16 + g) * 64 + lane];
            acc[qg][rb][g] = o; ss += o * o;
          }
        ss += __shfl_xor(ss, 32);
        const float rstd = rsqrtf(ss * (1.f / DV) + EPS) * oscale;
        u16* orow = Ob + (size_t)(qrow0 + qg * 32) * 1024;
#pragma unroll
        for (int rb = 0; rb < RB; ++rb)
#pragma unroll
          for (int g4 = 0; g4 < 4; ++g4) {
            int dv = rb * 32 + 8 * g4 + 4 * h;
            f32x4 gn = *(const f32x4*)(onorm + dv);
            u32x2 o = {pk2(acc[qg][rb][g4 * 4] * rstd * gn.x, acc[qg][rb][g4 * 4 + 1] * rstd * gn.y),
                       pk2(acc[qg][rb][g4 * 4 + 2] * rstd * gn.z, acc[qg][rb][g4 * 4 + 3] * rstd * gn.w)};
            *(u32x2*)(orow + dv) = o;
          }
      }
    }
    __syncthreads();
  }
}

DI void attnA_item(const Params& P, int i, int item, char* smem) {
  char* ws = P.ws;
  const u16* Q = (const u16*)(ws + W_Q);
  u16* O = (u16*)(ws + W_OMIX);
  int t0, head, ta0, ta1, tb0, tb1, vts, qpos0; bool window;
  const u16* Kb; const u16* VT;
  if (item < 512) {
    int n = item & 15, b = item >> 7; head = (item >> 4) & 7;
    int kv = head >> 2;
    t0 = NCTX + b * 4096 + n * 256;
    Kb = (const u16*)(ws + W_KA_DEC + i * SZ_KA_DEC) + (size_t)(b * 2 + kv) * 4608 * 64;
    VT = (const u16*)(ws + W_VAT_DEC + i * SZ_KA_DEC) + (size_t)(b * 2 + kv) * 64 * 4608;
    ta0 = max(0, 4 * n - 2); ta1 = min(64, 4 * n + 6); tb0 = 64; tb1 = 72; vts = 4608; window = true; qpos0 = n * 256;
  } else {
    int it = item - 512;
    int b = it >> 3; head = it & 7;
    int kv = head >> 2;
    t0 = b * 256;
    Kb = (const u16*)(ws + W_KA_CTX) + (size_t)(b * 2 + kv) * 256 * 64;
    VT = (const u16*)(ws + W_VAT_CTX) + (size_t)(b * 2 + kv) * 64 * 256;
    ta0 = 0; ta1 = 4; tb0 = 0; tb1 = 0; vts = 256; window = false; qpos0 = 0;
  }
  float Mb = ((const float*)(ws + W_LAM))[2 + i];
  float sinkp = __builtin_amdgcn_exp2f(P.in[I_ASINK][i * 8 + head] * LOG2E - Mb);
  attn_item<64, false, 2>(Q + (size_t)t0 * 1024 + head * 64, Kb, 0, VT, vts, ta0, ta1, tb0, tb1, window, qpos0, Mb, sinkp, 0.f, nullptr, 1.f,
                          O + (size_t)t0 * 1024 + head * 64, smem);
}
DI void attnC_phase(const Params& P, int i, char* smem) {
  char* ws = P.ws;
  const u16* Q = (const u16*)(ws + W_Q);
  u16* O = (u16*)(ws + W_OMIX);
  const float lam = ((const float*)(ws + W_LAM))[i];
  const float oscale = 1.f - P.lam_init[i];
  const float* onorm = P.in[I_CON] + i * 128;
  const float Mb = ((const float*)(ws + W_LAM))[4 + i];
  const int xcd = blockIdx.x & 7, local = blockIdx.x >> 3, nloc = gridDim.x >> 3;
  for (int q = local; q < 4 * 32 + 64; q += nloc) {
    int t0, head, nt, tk;
    const u16* Kb; const u16* VT;
    if (q < 128) {
      const int pair = xcd + 8 * (q >> 5), n = q & 31, b = pair >> 3; head = pair & 7;
      t0 = NCTX + b * 4096 + n * 128;
      Kb = (const u16*)(ws + W_KC_DEC + i * SZ_KC_DEC) + (size_t)(b * 8 + head) * 2 * 4608 * 64;
      VT = (const u16*)(ws + W_VCT_DEC + i * SZ_KC_DEC) + (size_t)(b * 8 + head) * 128 * 4608;
      nt = 72; tk = 4608;
    } else {
      const int it = q - 128;
      const int pair = xcd + 8 * (it >> 1), n = it & 1, b = pair >> 3; head = pair & 7;
      t0 = b * 256 + n * 128;
      Kb = (const u16*)(ws + W_KC_CTX) + (size_t)(b * 8 + head) * 2 * 256 * 64;
      VT = (const u16*)(ws + W_VCT_CTX) + (size_t)(b * 8 + head) * 128 * 256;
      nt = 4; tk = 256;
    }
    attn_item<128, true, 2>(Q + (size_t)t0 * 1024 + head * 128, Kb, (size_t)tk * 64, VT, tk, 0, nt, 0, 0, false, 0, Mb, 0.f, lam, onorm, oscale,
                            O + (size_t)t0 * 1024 + head * 128, smem);
  }
}

DI float log_sigmoid_f(float z) { return fminf(z, 0.f) - log1pf(__expf(-fabsf(z))); }

DI void gla_gates(const Params& P, int i, int hd, int dir, const float* sBG, float* sB) {
  const int tid = threadIdx.x, d = tid & 63, jq = tid >> 6;
  const float* gw = P.in[dir ? I_GWB : I_GWF] + (size_t)i * 16 * 256 + hd * 64 + d;
  const float gb = P.in[dir ? I_GBB : I_GBF][i * 256 + hd * 64 + d];
  float w[16];
#pragma unroll
  for (int rr = 0; rr < 16; ++rr) w[rr] = gw[rr * 256];
  for (int j = jq * 16; j < jq * 16 + 16; ++j) {
    float z = gb;
#pragma unroll
    for (int rr = 0; rr < 16; ++rr) z += sBG[j * 33 + dir * 16 + rr] * w[rr];
    sB[j * 65 + d] = log_sigmoid_f(z) * (1.f / 16.f);
  }
  __syncthreads();
  if (tid < 64) {
    float run = 0.f;
    if (dir == 0) { for (int j = 0; j < 64; ++j) { run += sB[j * 65 + tid]; sB[j * 65 + tid] = run; } }
    else { for (int j = 63; j >= 0; --j) { run += sB[j * 65 + tid]; sB[j * 65 + tid] = run; } }
  }
  __syncthreads();
}
DI void gla_load_common(const Params& P, int t0, int hd, float* sBG, u16* sVT) {
  const int tid = threadIdx.x;
  const float* bg = (const float*)(P.ws + W_BG) + (size_t)t0 * 32;
  for (int idx = tid; idx < 2048; idx += 256) sBG[(idx >> 5) * 33 + (idx & 31)] = bg[idx];
  {
    int j = tid & 63, vg = tid >> 6;
    const u16* src = (const u16*)(P.ws + W_BV) + (size_t)(t0 + j) * 512 + hd * 128 + vg * 32;
#pragma unroll
    for (int q = 0; q < 4; ++q) {
      u32x4 u = *(const u32x4*)(src + q * 8);
      unsigned w4[4] = {u.x, u.y, u.z, u.w};
#pragma unroll
      for (int e = 0; e < 4; ++e) {
        sVT[(vg * 32 + q * 8 + e * 2) * 72 + j] = (u16)(w4[e] & 0xffffu);
        sVT[(vg * 32 + q * 8 + e * 2 + 1) * 72 + j] = (u16)(w4[e] >> 16);
      }
    }
  }
}

DI void gla_b1_item(const Params& P, int i, int item, char* smem) {
  const int cgk = item >> 2, hd = item & 3, t0 = cgk * 64;
  const int tid = threadIdx.x, lane = tid & 63, wave = tid >> 6, r = lane & 31, h = lane >> 5;
  u16* sVT = (u16*)smem;
  float* sBG = (float*)(smem + 18432);
  float* sB = (float*)(smem + 18432 + 8448);
  u16* sKT = (u16*)(smem + 18432 + 8448 + 16640);
  gla_load_common(P, t0, hd, sBG, sVT);
  __syncthreads();
  for (int dir = 0; dir < 2; ++dir) {
    gla_gates(P, i, hd, dir, sBG, sB);
    {
      int d = tid & 63, jq = tid >> 6;
      float tot = (dir == 0) ? sB[63 * 65 + d] : sB[d];
      const u16* kp = (const u16*)(P.ws + W_BK) + (size_t)t0 * 256 + hd * 64 + d;
      for (int j = jq * 16; j < jq * 16 + 16; ++j) {
        float kvv = bf2f(kp[(size_t)j * 256]);
        sKT[d * 72 + j] = f2bf(kvv * __expf(tot - sB[j * 65 + d]));
      }
      if (jq == 0) ((float*)(P.ws + W_DEC))[((size_t)item * 2 + dir) * 64 + d] = __expf(tot);
    }
    __syncthreads();
    {
      int dblk = wave >> 1, vh = wave & 1;
      f32x16 acc[2];
#pragma unroll
      for (int jv = 0; jv < 2; ++jv)
#pragma unroll
        for (int g = 0; g < 16; ++g) acc[jv][g] = 0.f;
#pragma unroll
      for (int ks = 0; ks < 4; ++ks) {
        bf16x8 a = ld8(sKT + (dblk * 32 + r) * 72 + ks * 16 + h * 8);
#pragma unroll
        for (int jv = 0; jv < 2; ++jv) {
          bf16x8 bb = ld8(sVT + (vh * 64 + jv * 32 + r) * 72 + ks * 16 + h * 8);
          acc[jv] = MFMA(a, bb, acc[jv]);
        }
      }
      float* kvo = (float*)(P.ws + W_KV) + ((size_t)item * 2 + dir) * 8192;
#pragma unroll
      for (int jv = 0; jv < 2; ++jv)
#pragma unroll
        for (int g = 0; g < 16; ++g) kvo[(dblk * 32 + crow(g, h)) * 128 + vh * 64 + jv * 32 + r] = acc[jv][g];
    }
    __syncthreads();
  }
}

DI void gla_scan_phase(const Params& P, int i) {
  const int tid = threadIdx.x;
  for (int item = blockIdx.x; item < 36 * 4 * 2 * 8; item += gridDim.x) {
    int slab = item & 7, dir = (item >> 3) & 1, hd = (item >> 4) & 3, seq = item >> 6;
    int cg0, NC, b, isdec;
    if (seq < 32) { isdec = 0; b = seq; cg0 = b * 4; NC = 4; } else { isdec = 1; b = seq - 32; cg0 = 128 + b * 64; NC = 64; }
    int e = slab * 1024 + tid * 4, d = e >> 7;
    f32x4 s = {0.f, 0.f, 0.f, 0.f};
    if (isdec) s = *(const f32x4*)(P.in[dir ? I_SBB : I_SBF] + (((size_t)b * 2 + i) * 4 + hd) * 8192 + e);
    float* kvb = (float*)(P.ws + W_KV);
    const float* decb = (const float*)(P.ws + W_DEC);
    for (int n4 = 0; n4 < NC; n4 += 4) {
      f32x4 tmp[4]; float dc[4];
#pragma unroll
      for (int u = 0; u < 4; ++u) {
        int n = dir ? (NC - 1 - (n4 + u)) : (n4 + u);
        size_t ci = ((size_t)(cg0 + n) * 4 + hd) * 2 + dir;
        tmp[u] = *(const f32x4*)(kvb + ci * 8192 + e);
        dc[u] = decb[ci * 64 + d];
      }
#pragma unroll
      for (int u = 0; u < 4; ++u) {
        int n = dir ? (NC - 1 - (n4 + u)) : (n4 + u);
        size_t ci = ((size_t)(cg0 + n) * 4 + hd) * 2 + dir;
        *(f32x4*)(kvb + ci * 8192 + e) = s;
        s.x = dc[u] * s.x + tmp[u].x; s.y = dc[u] * s.y + tmp[u].y; s.z = dc[u] * s.z + tmp[u].z; s.w = dc[u] * s.w + tmp[u].w;
      }
    }
    if (!isdec) *(f32x4*)(P.out + (dir ? O_SBB : O_SBF) + (((size_t)b * 2 + i) * 4 + hd) * 8192 + e) = s;
  }
}

DI void gla_b3_item(const Params& P, int i, int item, char* smem) {
  const int cgk = item >> 2, hd = item & 3, t0 = cgk * 64;
  const int tid = threadIdx.x, lane = tid & 63, wave = tid >> 6, r = lane & 31, h = lane >> 5;
  u16* sVT = (u16*)smem;
  u16* sA = (u16*)(smem + 18432);
  float* sBG = (float*)(smem + 27648);
  float* sB = (float*)(smem + 36096);
  u16* sQD = (u16*)(smem + 52736);
  u16* sKD = (u16*)(smem + 61952);
  float* sO = (float*)(smem + 36096);
  gla_load_common(P, t0, hd, sBG, sVT);
  __syncthreads();
  const int iblk = wave >> 1, jblk = wave & 1;
  f32x16 aacc[2], oacc[2];
#pragma unroll
  for (int u = 0; u < 2; ++u)
#pragma unroll
    for (int g = 0; g < 16; ++g) { aacc[u][g] = 0.f; oacc[u][g] = 0.f; }
#pragma unroll
  for (int dir = 0; dir < 2; ++dir) {
    gla_gates(P, i, hd, dir, sBG, sB);
    {
      int d = tid & 63, jq = tid >> 6;
      const u16* qp = (const u16*)(P.ws + W_BQ) + (size_t)t0 * 256 + hd * 64 + d;
      const u16* kp = (const u16*)(P.ws + W_BK) + (size_t)t0 * 256 + hd * 64 + d;
      for (int j = jq * 16; j < jq * 16 + 16; ++j) {
        float bb = sB[j * 65 + d];
        sQD[j * 72 + d] = f2bf(bf2f(qp[(size_t)j * 256]) * __expf(bb));
        sKD[j * 72 + d] = f2bf(bf2f(kp[(size_t)j * 256]) * __expf(-bb));
      }
    }
    __syncthreads();
#pragma unroll
    for (int ks = 0; ks < 4; ++ks) {
      bf16x8 a = ld8(sQD + (iblk * 32 + r) * 72 + ks * 16 + h * 8);
      bf16x8 bb = ld8(sKD + (jblk * 32 + r) * 72 + ks * 16 + h * 8);
      aacc[dir] = MFMA(a, bb, aacc[dir]);
    }
    const float* S = (const float*)(P.ws + W_KV) + ((size_t)item * 2 + dir) * 8192 + wave * 32 + r;
#pragma unroll
    for (int ks = 0; ks < 4; ++ks) {
      float sv[8];
#pragma unroll
      for (int jj = 0; jj < 8; ++jj) sv[jj] = S[(size_t)(ks * 16 + h * 8 + jj) * 128];
      u32x4 u = {pk2(sv[0], sv[1]), pk2(sv[2], sv[3]), pk2(sv[4], sv[5]), pk2(sv[6], sv[7])};
      bf16x8 bfr = __builtin_bit_cast(bf16x8, u);
#pragma unroll
      for (int it = 0; it < 2; ++it) {
        bf16x8 a = ld8(sQD + (it * 32 + r) * 72 + ks * 16 + h * 8);
        oacc[it] = MFMA(a, bfr, oacc[it]);
      }
    }
    __syncthreads();
  }
#pragma unroll
  for (int g = 0; g < 16; ++g) {
    int ii = iblk * 32 + crow(g, h), jj = jblk * 32 + r;
    float v = (jj <= ii ? aacc[0][g] : 0.f) + (jj >= ii ? aacc[1][g] : 0.f);
    sA[ii * 72 + jj] = f2bf(v);
  }
  __syncthreads();
#pragma unroll
  for (int ks = 0; ks < 4; ++ks) {
    bf16x8 bb = ld8(sVT + (wave * 32 + r) * 72 + ks * 16 + h * 8);
#pragma unroll
    for (int it = 0; it < 2; ++it) {
      bf16x8 a = ld8(sA + (it * 32 + r) * 72 + ks * 16 + h * 8);
      oacc[it] = MFMA(a, bb, oacc[it]);
    }
  }
#pragma unroll
  for (int it = 0; it < 2; ++it)
#pragma unroll
    for (int g = 0; g < 16; ++g) sO[(it * 32 + crow(g, h)) * 129 + wave * 32 + r] = oacc[it][g];
  __syncthreads();
  {
    int ii = tid >> 2, seg = tid & 3;
    float v[32]; float ss = 0.f;
#pragma unroll
    for (int c = 0; c < 32; ++c) { v[c] = sO[ii * 129 + seg * 32 + c]; ss += v[c] * v[c]; }
    ss += __shfl_xor(ss, 1); ss += __shfl_xor(ss, 2);
    float rstd = rsqrtf(ss * (1.f / 128.f) + EPS);
    const float* gn = P.in[I_BON] + i * 128 + seg * 32;
    const u16* br = (const u16*)(P.ws + W_BR) + (size_t)(t0 + ii) * 512 + hd * 128 + seg * 32;
    u16* o = (u16*)(P.ws + W_OMIX) + (size_t)(t0 + ii) * 1024 + 512 + hd * 128 + seg * 32;
#pragma unroll
    for (int q = 0; q < 4; ++q) {
      u32x4 bu = *(const u32x4*)(br + q * 8);
      unsigned bw[4] = {bu.x, bu.y, bu.z, bu.w};
      unsigned ow[4];
#pragma unroll
      for (int e = 0; e < 4; ++e) {
        int c = q * 8 + e * 2;
        float o0 = v[c] * rstd * gn[c] * silu_f(bflo(bw[e]));
        float o1 = v[c + 1] * rstd * gn[c + 1] * silu_f(bfhi(bw[e]));
        ow[e] = pk2(o0, o1);
      }
      u32x4 ou = {ow[0], ow[1], ow[2], ow[3]};
      *(u32x4*)(o + q * 8) = ou;
    }
  }
  __syncthreads();
}

DI unsigned f2key(float f) { unsigned b = __float_as_uint(f); return b ^ ((unsigned)((int)b >> 31) | 0x80000000u); }
DI float key2f(unsigned k) { unsigned b = (k & 0x80000000u) ? (k ^ 0x80000000u) : ~k; return __uint_as_float(b); }
DI void ce_desc(unsigned& x, unsigned& y) { unsigned mx = max(x, y), mn = min(x, y); x = mx; y = mn; }
template <int B, int N>
DI void sort16_desc(unsigned (&a)[N]) {
#pragma unroll
  for (int k = 2; k <= 16; k <<= 1)
#pragma unroll
    for (int j = k >> 1; j > 0; j >>= 1)
#pragma unroll
      for (int i = 0; i < 16; ++i) {
        const int l = i ^ j;
        if (l > i) {
          if ((i & k) == 0) ce_desc(a[B + i], a[B + l]); else ce_desc(a[B + l], a[B + i]);
        }
      }
}
template <int A, int Bo, int N>
DI void merge16_desc(unsigned (&a)[N]) {
#pragma unroll
  for (int i = 0; i < 16; ++i) a[A + i] = max(a[A + i], a[Bo + 15 - i]);
#pragma unroll
  for (int j = 8; j > 0; j >>= 1)
#pragma unroll
    for (int i = 0; i < 16; ++i) {
      const int l = i ^ j;
      if (l > i) ce_desc(a[A + i], a[A + l]);
    }
}
DI void top16_of_64(unsigned (&a)[64]) {
  sort16_desc<0>(a); sort16_desc<16>(a); sort16_desc<32>(a); sort16_desc<48>(a);
  merge16_desc<0, 16>(a); merge16_desc<32, 48>(a); merge16_desc<0, 32>(a);
}

DI void peer_topk_phase(const Params& P, int l, char* smem) {
  const int tid = threadIdx.x, lane = tid & 63, wave = tid >> 6, r = lane & 31, h = lane >> 5;
  const u16* Q = (const u16*)(P.ws + W_Q);
  const u16* SK = (const u16*)(P.ws + W_SK) + (size_t)l * 8 * 2 * 128 * 64;
  for (int wi = blockIdx.x * 4 + wave; wi < (NTOK / 32) * 8; wi += gridDim.x * 4) {
    const int hd = wi & 7, t0 = (wi >> 3) * 32;
    unsigned lst[2][16];
    f32x16 accp[2][4];
    {
      bf16x8 bq[2][4], ak[2][4][4];
#pragma unroll
      for (int p = 0; p < 2; ++p)
#pragma unroll
        for (int ks = 0; ks < 4; ++ks) {
          bq[p][ks] = ld8(Q + (size_t)(t0 + r) * 1024 + hd * 128 + p * 64 + ks * 16 + h * 8);
#pragma unroll
          for (int kt = 0; kt < 4; ++kt) ak[p][ks][kt] = ld8(SK + ((size_t)(hd * 2 + p) * 128 + kt * 32 + r) * 64 + ks * 16 + h * 8);
        }
#pragma unroll
      for (int p = 0; p < 2; ++p) {
#pragma unroll
        for (int kt = 0; kt < 4; ++kt)
#pragma unroll
          for (int g = 0; g < 16; ++g) accp[p][kt][g] = 0.f;
#pragma unroll
        for (int ks = 0; ks < 4; ++ks)
#pragma unroll
          for (int kt = 0; kt < 4; ++kt) accp[p][kt] = MFMA(ak[p][ks][kt], bq[p][ks], accp[p][kt]);
      }
    }
#pragma unroll
    for (int p = 0; p < 2; ++p) {
      f32x16 (&acc)[4] = accp[p];
      unsigned a[64];
#pragma unroll
      for (int kt = 0; kt < 4; ++kt)
#pragma unroll
        for (int g = 0; g < 16; ++g) {
          const int key = kt * 32 + crow(g, h);
          a[kt * 16 + g] = (f2key(acc[kt][g]) & ~127u) | (unsigned)(127 - key);
        }
      top16_of_64(a);
#pragma unroll
      for (int i = 0; i < 16; ++i) a[16 + i] = (unsigned)__shfl_xor((int)a[i], 32);
      merge16_desc<0, 16>(a);
#pragma unroll
      for (int i = 0; i < 16; ++i) lst[p][i] = a[i];
    }
    unsigned c[64];
    {
      float v0[16], v1[16];
#pragma unroll
      for (int k = 0; k < 16; ++k) { v0[k] = key2f(lst[0][k] & ~127u); v1[k] = key2f(lst[1][k] & ~127u); }
      int n = 0;
#pragma unroll
      for (int a = 0; a < 16; ++a)
#pragma unroll
        for (int b = 0; b < 16; ++b)
          if ((a + 1) * (b + 1) <= 16) {
            const unsigned i0 = 127u - (lst[0][a] & 127u), i1 = 127u - (lst[1][b] & 127u);
            c[n] = (f2key(v0[a] + v1[b]) & 0xFFFFC000u) | (i0 << 7) | i1;
            ++n;
          }
#pragma unroll
      for (int k = 50; k < 64; ++k) c[k] = 0u;
    }
    top16_of_64(c);
    float fs[16];
    const float mx = key2f(c[0] & 0xFFFFC000u);
    float sum = 0.f;
#pragma unroll
    for (int k = 0; k < 16; ++k) { fs[k] = __expf(key2f(c[k] & 0xFFFFC000u) - mx); sum += fs[k]; }
    const float inv = 1.f / sum;
    const size_t ob = (size_t)(t0 + r) * 128 + hd * 16;
    if (h == 0) {
      int* eo = (int*)(P.ws + W_EIDX) + ob;
#pragma unroll
      for (int q = 0; q < 4; ++q) {
        u32x4 o = {c[q * 4] & 0x3FFFu, c[q * 4 + 1] & 0x3FFFu, c[q * 4 + 2] & 0x3FFFu, c[q * 4 + 3] & 0x3FFFu};
        *(u32x4*)(eo + q * 4) = o;
      }
    } else {
      float* go = (float*)(P.ws + W_EGATE) + ob;
#pragma unroll
      for (int q = 0; q < 4; ++q) {
        f32x4 o = {fs[q * 4] * inv, fs[q * 4 + 1] * inv, fs[q * 4 + 2] * inv, fs[q * 4 + 3] * inv};
        *(f32x4*)(go + q * 4) = o;
      }
    }
  }
}

DI float dpp_add(float e, float v, int) { return e + v; }
#define DPP_ADD(e, ctrl) ((e) + __int_as_float(__builtin_amdgcn_update_dpp(0, __float_as_int(e), (ctrl), 0xf, 0xf, true)))
DI float reduce4(float d0, float d1, float d2, float d3, int lane) {
  auto r01 = __builtin_amdgcn_permlane32_swap(__float_as_uint(d0), __float_as_uint(d1), false, false);
  const float a = __uint_as_float(r01[0]) + __uint_as_float(r01[1]);
  auto r23 = __builtin_amdgcn_permlane32_swap(__float_as_uint(d2), __float_as_uint(d3), false, false);
  const float c = __uint_as_float(r23[0]) + __uint_as_float(r23[1]);
  auto rq = __builtin_amdgcn_permlane16_swap(__float_as_uint(a), __float_as_uint(c), false, false);
  float e = __uint_as_float(rq[0]) + __uint_as_float(rq[1]);
  e = DPP_ADD(e, 0xB1);
  e = DPP_ADD(e, 0x4E);
  e = DPP_ADD(e, 0x141);
  e = DPP_ADD(e, 0x140);
  return e;
}
DI float dot16_fp8(const u32x4& w, const f32x2_t (&h2)[8]) {
  f32x2_t acc0 = {0.f, 0.f}, acc1 = {0.f, 0.f};
  acc0 = __builtin_amdgcn_cvt_pk_f32_fp8((int)w.x, false) * h2[0] + acc0;
  acc1 = __builtin_amdgcn_cvt_pk_f32_fp8((int)w.x, true) * h2[1] + acc1;
  acc0 = __builtin_amdgcn_cvt_pk_f32_fp8((int)w.y, false) * h2[2] + acc0;
  acc1 = __builtin_amdgcn_cvt_pk_f32_fp8((int)w.y, true) * h2[3] + acc1;
  acc0 = __builtin_amdgcn_cvt_pk_f32_fp8((int)w.z, false) * h2[4] + acc0;
  acc1 = __builtin_amdgcn_cvt_pk_f32_fp8((int)w.z, true) * h2[5] + acc1;
  acc0 = __builtin_amdgcn_cvt_pk_f32_fp8((int)w.w, false) * h2[6] + acc0;
  acc1 = __builtin_amdgcn_cvt_pk_f32_fp8((int)w.w, true) * h2[7] + acc1;
  acc0 += acc1;
  return acc0.x + acc0.y;
}
DI void axpy16_fp8(const u32x4& w, float s, f32x2_t (&y2)[8]) {
  const f32x2_t s2 = {s, s};
  y2[0] = __builtin_amdgcn_cvt_pk_f32_fp8((int)w.x, false) * s2 + y2[0];
  y2[1] = __builtin_amdgcn_cvt_pk_f32_fp8((int)w.x, true) * s2 + y2[1];
  y2[2] = __builtin_amdgcn_cvt_pk_f32_fp8((int)w.y, false) * s2 + y2[2];
  y2[3] = __builtin_amdgcn_cvt_pk_f32_fp8((int)w.y, true) * s2 + y2[3];
  y2[4] = __builtin_amdgcn_cvt_pk_f32_fp8((int)w.z, false) * s2 + y2[4];
  y2[5] = __builtin_amdgcn_cvt_pk_f32_fp8((int)w.z, true) * s2 + y2[5];
  y2[6] = __builtin_amdgcn_cvt_pk_f32_fp8((int)w.w, false) * s2 + y2[6];
  y2[7] = __builtin_amdgcn_cvt_pk_f32_fp8((int)w.w, true) * s2 + y2[7];
}

DI void axpy16_fp4(const u32x2& w, float s, f32x2_t (&y2)[8]) {
  const f32x2_t s2 = {s, s};
  y2[0] = __builtin_amdgcn_cvt_scalef32_pk_f32_fp4(w.x, 1.0f, 0) * s2 + y2[0];
  y2[1] = __builtin_amdgcn_cvt_scalef32_pk_f32_fp4(w.x, 1.0f, 1) * s2 + y2[1];
  y2[2] = __builtin_amdgcn_cvt_scalef32_pk_f32_fp4(w.x, 1.0f, 2) * s2 + y2[2];
  y2[3] = __builtin_amdgcn_cvt_scalef32_pk_f32_fp4(w.x, 1.0f, 3) * s2 + y2[3];
  y2[4] = __builtin_amdgcn_cvt_scalef32_pk_f32_fp4(w.y, 1.0f, 0) * s2 + y2[4];
  y2[5] = __builtin_amdgcn_cvt_scalef32_pk_f32_fp4(w.y, 1.0f, 1) * s2 + y2[5];
  y2[6] = __builtin_amdgcn_cvt_scalef32_pk_f32_fp4(w.y, 1.0f, 2) * s2 + y2[6];
  y2[7] = __builtin_amdgcn_cvt_scalef32_pk_f32_fp4(w.y, 1.0f, 3) * s2 + y2[7];
}
DI void peer_expert_phase(const Params& P, int l) {
  const int lane = threadIdx.x & 63, wave = threadIdx.x >> 6;
  const char* U = P.ws + W_PU + (size_t)l * 16384 * 1536 + lane * 16;
  const char* V = P.ws + W_PU + (size_t)l * 16384 * 1536 + 1024 + lane * 8;
  const float* SU = (const float*)(P.ws + W_PSU) + l * 16384;
  const float* SV = (const float*)(P.ws + W_PSV) + l * 16384;
  float* x = P.out + O_X;
  const int grp = lane >> 4;
  const int tstride = gridDim.x * 4;
  int ni0, ni1; float ng0, ng1; u32x4 nhA, nhB;
  {
    const int tl = min(blockIdx.x * 4 + wave, NTOK - 1);
    const u16* hrow = (const u16*)(P.ws + W_H) + (size_t)tl * 1024 + lane * 16;
    nhA = *(const u32x4*)hrow; nhB = *(const u32x4*)(hrow + 8);
    const int* ei = (const int*)(P.ws + W_EIDX) + (size_t)tl * 128;
    const float* eg = (const float*)(P.ws + W_EGATE) + (size_t)tl * 128;
    ni0 = ei[lane]; ni1 = ei[64 + lane]; ng0 = eg[lane]; ng1 = eg[64 + lane];
  }
  u32x4 un[16]; u32x2 vn[16];
#pragma unroll
  for (int u = 0; u < 16; ++u) {
    const int id = __builtin_amdgcn_readlane(ni0, u);
    un[u] = *(const u32x4*)(U + (size_t)id * 1536);
    vn[u] = *(const u32x2*)(V + (size_t)id * 1536);
  }
  float nsu0 = SU[ni0], nsu1 = SU[ni1], nsv0 = SV[ni0], nsv1 = SV[ni1];
  for (int t = blockIdx.x * 4 + wave; t < NTOK; t += tstride) {
    int isdec, b, s, mi; tokinfo(t, isdec, b, s, mi);
    const u32x4 hA = nhA, hB = nhB;
    const int myi0 = ni0, myi1 = ni1;
    const float graw0 = ng0, graw1 = ng1;
    {
      const int tn = min(t + tstride, NTOK - 1);
      const u16* hrow = (const u16*)(P.ws + W_H) + (size_t)tn * 1024 + lane * 16;
      nhA = *(const u32x4*)hrow; nhB = *(const u32x4*)(hrow + 8);
      const int* ei = (const int*)(P.ws + W_EIDX) + (size_t)tn * 128;
      const float* eg = (const float*)(P.ws + W_EGATE) + (size_t)tn * 128;
      ni0 = ei[lane]; ni1 = ei[64 + lane]; ng0 = eg[lane]; ng1 = eg[64 + lane];
    }
    f32x2_t h2[8] = {{bflo(hA.x), bfhi(hA.x)}, {bflo(hA.y), bfhi(hA.y)}, {bflo(hA.z), bfhi(hA.z)}, {bflo(hA.w), bfhi(hA.w)},
                     {bflo(hB.x), bfhi(hB.x)}, {bflo(hB.y), bfhi(hB.y)}, {bflo(hB.z), bfhi(hB.z)}, {bflo(hB.w), bfhi(hB.w)}};
    const float mysu0 = nsu0, mysu1 = nsu1;
    const float myg0 = graw0 * nsv0, myg1 = graw1 * nsv1;
    f32x2_t y2[8];
#pragma unroll
    for (int j = 0; j < 8; ++j) { y2[j].x = 0.f; y2[j].y = 0.f; }
    for (int e0 = 0; e0 < 128; e0 += 16) {
      u32x4 uc[16]; u32x2 vc[16];
#pragma unroll
      for (int u = 0; u < 16; ++u) { uc[u] = un[u]; vc[u] = vn[u]; }
      {
        const int e1 = (e0 + 16) & 127;
        const int srci = (e0 + 16 < 128) ? ((e1 < 64) ? myi0 : myi1) : ni0;
#pragma unroll
        for (int u = 0; u < 16; ++u) {
          const int id = __builtin_amdgcn_readlane(srci, (e1 + u) & 63);
          un[u] = *(const u32x4*)(U + (size_t)id * 1536);
          vn[u] = *(const u32x2*)(V + (size_t)id * 1536);
        }
      }
      if (e0 == 64) { nsu0 = SU[ni0]; nsu1 = SU[ni1]; nsv0 = SV[ni0]; nsv1 = SV[ni1]; }
      const float gsrc = (e0 < 64) ? myg0 : myg1;
      const float ssrc = (e0 < 64) ? mysu0 : mysu1;
#pragma unroll
      for (int hb = 0; hb < 4; ++hb) {
        float su[4], gt[4];
#pragma unroll
        for (int u = 0; u < 4; ++u) {
          su[u] = __int_as_float(__builtin_amdgcn_readlane(__float_as_int(ssrc), (e0 + hb * 4 + u) & 63));
          gt[u] = __int_as_float(__builtin_amdgcn_readlane(__float_as_int(gsrc), (e0 + hb * 4 + u) & 63));
        }
        float d0 = dot16_fp8(uc[hb * 4 + 0], h2), d1 = dot16_fp8(uc[hb * 4 + 1], h2), d2 = dot16_fp8(uc[hb * 4 + 2], h2), d3 = dot16_fp8(uc[hb * 4 + 3], h2);
        float e = reduce4(d0, d1, d2, d3, lane);
        const float su_s = (grp == 0) ? su[0] : (grp == 1) ? su[2] : (grp == 2) ? su[1] : su[3];
        const float w_s = (grp == 0) ? gt[0] : (grp == 1) ? gt[2] : (grp == 2) ? gt[1] : gt[3];
        const float pre = e * su_s;
        const float act = 0.5f * pre * (1.f + erff(pre * 0.70710678118654752f));
        const float w = act * w_s;
        const float w0 = __int_as_float(__builtin_amdgcn_readlane(__float_as_int(w), 0));
        const float w1 = __int_as_float(__builtin_amdgcn_readlane(__float_as_int(w), 32));
        const float w2 = __int_as_float(__builtin_amdgcn_readlane(__float_as_int(w), 16));
        const float w3 = __int_as_float(__builtin_amdgcn_readlane(__float_as_int(w), 48));
        axpy16_fp4(vc[hb * 4 + 0], w0, y2); axpy16_fp4(vc[hb * 4 + 1], w1, y2); axpy16_fp4(vc[hb * 4 + 2], w2, y2); axpy16_fp4(vc[hb * 4 + 3], w3, y2);
      }
    }
    const float* g2 = (const float*)(P.ws + W_MOD) + ((size_t)l * 5 + mi) * 6144 + 5 * 1024 + lane * 16;
    float* xr = x + (size_t)t * 1024 + lane * 16;
    float xn[16];
#pragma unroll
    for (int q = 0; q < 4; ++q) {
      f32x4 xv = *(const f32x4*)(xr + q * 4), gv = *(const f32x4*)(g2 + q * 4);
      xv.x += gv.x * y2[q * 2].x; xv.y += gv.y * y2[q * 2].y; xv.z += gv.z * y2[q * 2 + 1].x; xv.w += gv.w * y2[q * 2 + 1].y;
      *(f32x4*)(xr + q * 4) = xv;
      xn[q * 4] = xv.x; xn[q * 4 + 1] = xv.y; xn[q * 4 + 2] = xv.z; xn[q * 4 + 3] = xv.w;
    }
    if (l < 3) {
      float ss = 0.f;
#pragma unroll
      for (int j = 0; j < 16; ++j) ss += xn[j] * xn[j];
      ss = wave_sum(ss);
      float rstd = rsqrtf(ss * (1.f / 1024.f) + EPS);
      const float* g = P.in[I_NMG] + (l + 1) * 1024 + lane * 16;
      const float* mod = (const float*)(P.ws + W_MOD) + ((size_t)(l + 1) * 5 + mi) * 6144 + lane * 16;
      u16* hh = (u16*)(P.ws + W_H) + (size_t)t * 1024 + lane * 16;
#pragma unroll
      for (int hf = 0; hf < 2; ++hf) {
        float o[8];
#pragma unroll
        for (int q = 0; q < 8; ++q) o[q] = xn[hf * 8 + q] * rstd * g[hf * 8 + q] * (1.f + mod[1024 + hf * 8 + q]) + mod[hf * 8 + q];
        u32x4 ou = {pk2(o[0], o[1]), pk2(o[2], o[3]), pk2(o[4], o[5]), pk2(o[6], o[7])};
        *(u32x4*)(hh + hf * 8) = ou;
      }
    }
  }
}

DI void mixer1_phase(const Params& P, int i, char* smem) {
  const int xcd = blockIdx.x & 7, nloc = gridDim.x >> 3;
  for (int q = blockIdx.x >> 3; q < 96; q += nloc) {
    int item;
    if (q < 64) { const int b = xcd >> 1, head = (xcd & 1) * 4 + (q >> 4), n = q & 15; item = b * 128 + head * 16 + n; }
    else { const int it = q - 64, b = xcd + 8 * (it >> 3), head = it & 7; item = 512 + b * 8 + head; }
    attnA_item(P, i, item, smem);
  }
  for (int item = blockIdx.x; item < 1536; item += gridDim.x) gla_b1_item(P, i, item, smem);
}

#define XB_TMO      128
#define XB_XCNT(j)  (256  + 64 * (j))
#define XB_XSUB(j)  (1280 + 64 * (j))
#define XB_XGEN(j)  (2304 + 64 * (j))
#define XB_TOP      3328
#define XB_TOPGEN   3392
#define XCD_BAR_WORDS 3456
#define XB_SPIN_CAP (1u << 20)
#define LAS __attribute__((address_space(3)))
DI unsigned xb_ld(unsigned* p)              { return __hip_atomic_load(p, __ATOMIC_RELAXED, __HIP_MEMORY_SCOPE_AGENT); }
DI unsigned xb_add(unsigned* p, unsigned v) { return __hip_atomic_fetch_add(p, v, __ATOMIC_RELAXED, __HIP_MEMORY_SCOPE_AGENT); }
DI unsigned xb_xcc_id() { return (unsigned)__builtin_amdgcn_s_getreg((3 << 11) | 20) & 0xFu; }
#define XB_SPIN(cond, bar) do { unsigned _sp = 0; while (cond) { __builtin_amdgcn_s_sleep(1); \
    if ((++_sp & 255u) == 0u) { if (xb_ld(&(bar)[XB_TMO])) break; if (_sp > XB_SPIN_CAP) { atomicAdd(&(bar)[XB_TMO], 1u); break; } } } } while (0)
struct XcdBarrier { unsigned* bar; unsigned x; volatile LAS unsigned* st; };
DI XcdBarrier xcd_barrier_post(unsigned* bar, volatile LAS unsigned* st) {
  XcdBarrier b; b.bar = bar; b.x = xb_xcc_id(); b.st = st;
  if (threadIdx.x == 0) (void)xb_add(&bar[XB_XCNT(b.x)], 1u);
  return b;
}
DI XcdBarrier make_xb(const Params& P, char* smem) {
  XcdBarrier b; b.bar = (unsigned*)(P.ws + W_BAR); b.x = xb_xcc_id(); b.st = (volatile LAS unsigned*)(smem + SMEM_BYTES - 16);
  return b;
}
DI void xcd_barrier_complete(unsigned* bar, unsigned x, unsigned& nloc, unsigned& nx) {
  const unsigned G = gridDim.x * gridDim.y * gridDim.z;
  unsigned sum, cnt, mine, sp = 0u;
  for (;;) {
    sum = 0u; cnt = 0u; mine = 0u;
#pragma unroll
    for (unsigned j = 0; j < 16; ++j) { const unsigned c = xb_ld(&bar[XB_XCNT(j)]); sum += c; cnt += (c > 0u) ? 1u : 0u; mine = (j == x) ? c : mine; }
    if (sum == G) break;
    __builtin_amdgcn_s_sleep(1);
    if ((++sp & 255u) == 0u) { if (xb_ld(&bar[XB_TMO])) break; if (sp > XB_SPIN_CAP) { atomicAdd(&bar[XB_TMO], 1u); break; } }
  }
  nloc = mine > 0u ? mine : 1u; nx = cnt > 0u ? cnt : 1u;
}
DI void xcd_barrier(const XcdBarrier& b) {
  asm volatile("s_waitcnt vmcnt(0)" ::: "memory");
  __syncthreads();
  if (threadIdx.x == 0) {
    unsigned* bar = b.bar;
    __builtin_amdgcn_s_waitcnt(0);
    unsigned nloc = b.st[0], nx = b.st[1];
    if (nloc == 0u) { xcd_barrier_complete(bar, b.x, nloc, nx); b.st[0] = nloc; b.st[1] = nx; }
    const unsigned old = xb_add(&bar[XB_XSUB(b.x)], 1u);
    const unsigned gen = old / nloc;
    if (old + 1u == (gen + 1u) * nloc) {
      __builtin_amdgcn_fence(__ATOMIC_RELEASE, "agent");
      asm volatile("s_waitcnt vmcnt(0)" ::: "memory");
      const unsigned og = xb_add(&bar[XB_TOP], 1u);
      const unsigned tg = og / nx;
      if (og + 1u == (tg + 1u) * nx) xb_add(&bar[XB_TOPGEN], 1u);
      else XB_SPIN(xb_ld(&bar[XB_TOPGEN]) == tg, bar);
      __builtin_amdgcn_fence(__ATOMIC_ACQUIRE, "agent");
      xb_add(&bar[XB_XGEN(b.x)], 1u);
      asm volatile("s_waitcnt vmcnt(0)" ::: "memory");
    } else {
      XB_SPIN(xb_ld(&bar[XB_XGEN(b.x)]) == gen, bar);
      __builtin_amdgcn_fence(__ATOMIC_ACQUIRE, "agent");
      asm volatile("s_waitcnt vmcnt(0)" ::: "memory");
    }
  }
  __syncthreads();
}

#ifndef REP0
#define REP0 1
#define REP1 1
#define REP2 1
#define REP3 1
#define REP4 1
#define REP5 1
#define REP6 1
#endif
#define PHASE(body) { body; xcd_barrier(make_xb(P, smem)); }
#define PHASE_R(c, body) for (int r_ = 0; r_ < P.rep[c]; ++r_) { body; xcd_barrier(make_xb(P, smem)); }
template <int L>
DI void run_layer(const Params& P, char* smem) {
  constexpr int l = L, i = L >> 1;
  if ((l & 1) == 0) {
    PHASE_R(2, gemm_phase((const u16*)(P.ws + W_H), (const u16*)(P.ws + W_EIN) + (size_t)i * EIN_PAD * 1024, 19, EpiEvenIn{&P, i}, smem));
    PHASE_R(3, mixer1_phase(P, i, smem));
    PHASE(gla_scan_phase(P, i));
    PHASE_R(3, { for (int item = blockIdx.x; item < 1536; item += gridDim.x) gla_b3_item(P, i, item, smem); });
    PHASE(gemm_phase((const u16*)(P.ws + W_OMIX), (const u16*)(P.ws + W_EOUT) + (size_t)i * 1024 * 1024, 8, EpiOut{&P, l}, smem));
  } else {
    PHASE_R(2, gemm_phase((const u16*)(P.ws + W_H), (const u16*)(P.ws + W_OIN) + (size_t)i * 3072 * 1024, 24, EpiOddIn{&P, i}, smem));
    PHASE_R(4, attnC_phase(P, i, smem));
    PHASE(gemm_phase((const u16*)(P.ws + W_OMIX), (const u16*)(P.ws + W_OOUT) + (size_t)i * 1024 * 1024, 8, EpiOut{&P, l}, smem));
  }
  PHASE_R(1, modnorm_phase(P, l, 1));
  PHASE_R(5, gemm_phase((const u16*)(P.ws + W_H), (const u16*)(P.ws + W_PQ) + (size_t)l * 1024 * 1024, 8, EpiPQ{&P}, smem));
  PHASE_R(6, peer_topk_phase(P, l, smem));
  if (l < 3) { PHASE(peer_expert_phase(P, l)); } else { peer_expert_phase(P, l); }
}

__global__ void __launch_bounds__(256) trunk_megakernel(Params P) {
  cg::grid_group grid = cg::this_grid();
  __shared__ __attribute__((aligned(16))) char smem[SMEM_BYTES];
  if (threadIdx.x == 0) { u32x4 z = {0u, 0u, 0u, 0u}; *(u32x4*)(smem + SMEM_BYTES - 16) = z; }
  __syncthreads();
  (void)xcd_barrier_post((unsigned*)(P.ws + W_BAR), (volatile LAS unsigned*)(smem + SMEM_BYTES - 16));
  prep_phase(P, smem);
  xcd_barrier(make_xb(P, smem));
  if (P.rep[7] == 0x7fffffff) grid.sync();
  PHASE_R(1, modnorm_phase(P, 0, 0));
  run_layer<0>(P, smem);
  run_layer<1>(P, smem);
  run_layer<2>(P, smem);
  run_layer<3>(P, smem);
}
#undef PHASE
#undef PHASE_R

extern "C" void kernel_launch(void* const* d_in, const int* in_sizes, int n_in, void* d_out, int out_size, void* d_ws, size_t ws_size,
                              hipStream_t stream) {
  static int grid_blocks = 0;
  if (!grid_blocks) {
    int dev = 0, cus = 0, per_cu = 0;
    hipGetDevice(&dev);
    hipDeviceGetAttribute(&cus, hipDeviceAttributeMultiprocessorCount, dev);
    hipOccupancyMaxActiveBlocksPerMultiprocessor(&per_cu, trunk_megakernel, 256, 0);
    if (per_cu > 2) per_cu = 2;
    if (per_cu < 1) per_cu = 1;
    grid_blocks = (cus * per_cu) & ~7;
    if (grid_blocks < 8) grid_blocks = 8;
  }
  Params p{};
  for (int k = 0; k < N_IN; ++k) p.in[k] = (const float*)d_in[k];
  p.out = (float*)d_out;
  p.ws = (char*)d_ws;
  p.lam_init[0] = (float)(0.8 - 0.6 * std::exp(-0.3 * 1.0));
  p.lam_init[1] = (float)(0.8 - 0.6 * std::exp(-0.3 * 3.0));
  p.rep[0] = REP0; p.rep[1] = REP1; p.rep[2] = REP2; p.rep[3] = REP3; p.rep[4] = REP4; p.rep[5] = REP5; p.rep[6] = REP6; p.rep[7] = 1;
  hipMemsetAsync((char*)d_ws + W_BAR, 0, XCD_BAR_WORDS * sizeof(unsigned), stream);
  void* args[] = {&p};
  hipError_t e = hipLaunchCooperativeKernel((void*)trunk_megakernel, dim3(grid_blocks), dim3(256), args, 0, stream);
  if (e != hipSuccess) fprintf(stderr, "cooperative launch failed: %s (grid %d)\n", hipGetErrorString(e), grid_blocks);
}
```

```cpp
#include <hip/hip_runtime.h>
#include <hip/hip_cooperative_groups.h>
#include <cmath>
#include <cstdio>
namespace cg = cooperative_groups;

typedef unsigned short u16;
typedef short bf16x8 __attribute__((ext_vector_type(8)));
typedef float f32x16 __attribute__((ext_vector_type(16)));
typedef __bf16 bf16x2_t __attribute__((ext_vector_type(2)));
typedef float f32x2_t __attribute__((ext_vector_type(2)));
typedef unsigned u32x4 __attribute__((ext_vector_type(4)));
typedef unsigned u32x2 __attribute__((ext_vector_type(2)));
typedef float f32x4 __attribute__((ext_vector_type(4)));
#define DI __device__ __forceinline__
#define MFMA(a, b, c) __builtin_amdgcn_mfma_f32_32x32x16_bf16((a), (b), (c), 0, 0, 0)

constexpr int D = 1024;
constexpr int NTOK = 24576;
constexpr int NCTX = 8192;
constexpr int EIN_PAD = 2432;
constexpr float LOG2E = 1.4426950408889634f;
constexpr float QSCALE = 0.125f * LOG2E;
constexpr float EPS = 1e-6f;

enum { I_XP = 0, I_XS, I_CAK, I_CAV, I_SBF, I_SBB, I_CCK, I_CCV, I_C, I_CCTX, I_ADAW, I_ADAB, I_NMG, I_NFG, I_EWIN, I_EWOUT,
       I_AQN, I_AKN, I_ASINK, I_GWF, I_GBF, I_GWB, I_GBB, I_BON, I_OWIN, I_OWOUT, I_CQN, I_CKN, I_LQ1, I_LK1, I_LQ2, I_LK2, I_CON,
       I_PWQ, I_PSK, I_PU, I_PV, N_IN };

constexpr size_t O_X = 0;
constexpr size_t O_CAK = 25165824;
constexpr size_t O_CAV = 27262976;
constexpr size_t O_SBF = 29360128;
constexpr size_t O_SBB = 31457280;
constexpr size_t O_CCK = 33554432;
constexpr size_t O_CCV = 50331648;

constexpr size_t W_EIN = 0;
constexpr size_t W_OIN = W_EIN + 2ull * EIN_PAD * 1024 * 2;
constexpr size_t W_EOUT = W_OIN + 2ull * 3072 * 1024 * 2;
constexpr size_t W_OOUT = W_EOUT + 2ull * 1024 * 1024 * 2;
constexpr size_t W_PQ = W_OOUT + 2ull * 1024 * 1024 * 2;
constexpr size_t W_SK = W_PQ + 4ull * 1024 * 1024 * 2;
constexpr size_t W_PU = W_SK + 4ull * 8 * 2 * 128 * 64 * 2;
constexpr size_t W_PV = W_PU + 4ull * 16384 * 1024 * 2;
constexpr size_t W_MOD = W_PV + 4ull * 16384 * 1024 * 2;
constexpr size_t W_ROPE = W_MOD + 4ull * 5 * 6144 * 4;
constexpr size_t W_LAM = W_ROPE + 64 * 16 * 2 * 4;
constexpr size_t W_H = W_LAM + 256;
constexpr size_t W_Q = W_H + (size_t)NTOK * 1024 * 2;
constexpr size_t W_OMIX = W_Q + (size_t)NTOK * 1024 * 2;
constexpr size_t SZ_KA_DEC = 4ull * 2 * 4608 * 64 * 2;
constexpr size_t W_KA_DEC = W_OMIX + (size_t)NTOK * 1024 * 2;
constexpr size_t W_VAT_DEC = W_KA_DEC + 2 * SZ_KA_DEC;
constexpr size_t W_KA_CTX = W_VAT_DEC + 2 * SZ_KA_DEC;
constexpr size_t W_VAT_CTX = W_KA_CTX + 32ull * 2 * 256 * 64 * 2;
constexpr size_t SZ_KC_DEC = 4ull * 8 * 2 * 4608 * 64 * 2;
constexpr size_t W_KC_DEC = W_VAT_CTX + 32ull * 2 * 256 * 64 * 2;
constexpr size_t W_VCT_DEC = W_KC_DEC + 2 * SZ_KC_DEC;
constexpr size_t W_KC_CTX = W_VCT_DEC + 2 * SZ_KC_DEC;
constexpr size_t W_VCT_CTX = W_KC_CTX + 32ull * 8 * 2 * 256 * 64 * 2;
constexpr size_t W_BQ = W_VCT_CTX + 32ull * 8 * 128 * 256 * 2;
constexpr size_t W_BK = W_BQ + (size_t)NTOK * 256 * 2;
constexpr size_t W_BV = W_BK + (size_t)NTOK * 256 * 2;
constexpr size_t W_BR = W_BV + (size_t)NTOK * 512 * 2;
constexpr size_t W_BG = W_BR + (size_t)NTOK * 512 * 2;
constexpr size_t W_KV = W_BG + (size_t)NTOK * 32 * 4;
constexpr size_t W_DEC = W_KV + 1536ull * 2 * 8192 * 4;
constexpr size_t W_EIDX = W_DEC + 1536ull * 2 * 64 * 4;
constexpr size_t W_EGATE = W_EIDX + (size_t)NTOK * 128 * 4;
constexpr size_t W_PSU = W_EGATE + (size_t)NTOK * 128 * 4;
constexpr size_t W_PSV = W_PSU + 4ull * 16384 * 4;
constexpr size_t W_END = W_PSV + 4ull * 16384 * 4;
constexpr size_t W_BAR = W_END;
static_assert(W_BAR + 16384 < (1ull << 30), "workspace budget");

struct Params {
  const float* in[N_IN];
  float* out;
  char* ws;
  float lam_init[2];
  int rep[8];
};

constexpr int SMEM_BYTES = 256 * 129 * 4 + 512;

DI unsigned pk2(float a, float b) {
  f32x2_t v = {a, b};
  bf16x2_t r = __builtin_convertvector(v, bf16x2_t);
  return __builtin_bit_cast(unsigned, r);
}
DI u16 f2bf(float a) { return (u16)(pk2(a, 0.f) & 0xffffu); }
DI float bf2f(u16 v) { return __uint_as_float(((unsigned)v) << 16); }
DI float bflo(unsigned w) { return __uint_as_float(w << 16); }
DI float bfhi(unsigned w) { return __uint_as_float(w & 0xffff0000u); }
DI int crow(int g, int h) { return (g & 3) + 8 * (g >> 2) + 4 * h; }
DI int pi32(int r) { return (r & ~12) | ((r & 4) << 1) | ((r & 8) >> 1); }
DI bf16x8 ld8(const u16* p) { return __builtin_bit_cast(bf16x8, *(const u32x4*)p); }
DI float wave_sum(float v) {
#pragma unroll
  for (int o = 32; o >= 1; o >>= 1) v += __shfl_xor(v, o);
  return v;
}
DI float silu_f(float x) { return x / (1.f + __expf(-x)); }
DI float dot2bf(unsigned a, unsigned b, float acc) {
  return __builtin_amdgcn_fdot2_f32_bf16(__builtin_bit_cast(bf16x2_t, a), __builtin_bit_cast(bf16x2_t, b), acc, false);
}
DI void tokinfo(int t, int& isdec, int& b, int& s, int& mi) {
  if (t < NCTX) { isdec = 0; b = t >> 8; s = t & 255; mi = 0; }
  else { int u = t - NCTX; isdec = 1; b = u >> 12; s = u & 4095; mi = 1 + b; }
}

DI void transpose_w(const float* __restrict__ src, u16* __restrict__ dst, int N, int Npad) {
  size_t total = (size_t)Npad * 128;
  for (size_t idx = (size_t)blockIdx.x * blockDim.x + threadIdx.x; idx < total; idx += (size_t)gridDim.x * blockDim.x) {
    int n = (int)(idx % Npad), kc = (int)(idx / Npad);
    float v[8];
#pragma unroll
    for (int j = 0; j < 8; ++j) v[j] = (n < N) ? src[(size_t)(kc * 8 + j) * N + n] : 0.f;
    u32x4 o = {pk2(v[0], v[1]), pk2(v[2], v[3]), pk2(v[4], v[5]), pk2(v[6], v[7])};
    *(u32x4*)(dst + (size_t)n * 1024 + kc * 8) = o;
  }
}
DI void convert_bf16(const float* __restrict__ src, u16* __restrict__ dst, size_t n) {
  size_t n8 = n >> 3;
  for (size_t idx = (size_t)blockIdx.x * blockDim.x + threadIdx.x; idx < n8; idx += (size_t)gridDim.x * blockDim.x) {
    f32x4 a = ((const f32x4*)src)[idx * 2], b = ((const f32x4*)src)[idx * 2 + 1];
    u32x4 o = {pk2(a.x, a.y), pk2(a.z, a.w), pk2(b.x, b.y), pk2(b.z, b.w)};
    ((u32x4*)dst)[idx] = o;
  }
}

DI void prep_phase(const Params& P, char* smem) {
  char* ws = P.ws;
  const int tid = threadIdx.x;
  const size_t gtid = (size_t)blockIdx.x * blockDim.x + tid, gsz = (size_t)gridDim.x * blockDim.x;
  {
    float* sS = (float*)smem;
    float* sR = sS + 5 * 1024;
    for (int idx = tid; idx < 5 * 1024; idx += 256) {
      int ci = idx >> 10, k = idx & 1023;
      float c = (ci == 0) ? P.in[I_CCTX][k] : P.in[I_C][(ci - 1) * 1024 + k];
      sS[idx] = silu_f(c);
    }
    __syncthreads();
    float* mod = (float*)(ws + W_MOD);
    for (int item = blockIdx.x; item < 4 * 96; item += gridDim.x) {
      int l = item / 96, ch = item % 96;
      int col = tid & 63, kq = tid >> 6;
      const float* w = P.in[I_ADAW] + (size_t)l * 1024 * 6144 + ch * 64 + col;
      float a0 = 0, a1 = 0, a2 = 0, a3 = 0, a4 = 0;
#pragma unroll 16
      for (int k = kq * 256; k < kq * 256 + 256; ++k) {
        float wv = w[(size_t)k * 6144];
        a0 += sS[k] * wv; a1 += sS[1024 + k] * wv; a2 += sS[2048 + k] * wv; a3 += sS[3072 + k] * wv; a4 += sS[4096 + k] * wv;
      }
      sR[(kq * 5 + 0) * 64 + col] = a0; sR[(kq * 5 + 1) * 64 + col] = a1; sR[(kq * 5 + 2) * 64 + col] = a2;
      sR[(kq * 5 + 3) * 64 + col] = a3; sR[(kq * 5 + 4) * 64 + col] = a4;
      __syncthreads();
      for (int idx = tid; idx < 320; idx += 256) {
        int ci = idx >> 6, c2 = idx & 63;
        float s = sR[(0 * 5 + ci) * 64 + c2] + sR[(1 * 5 + ci) * 64 + c2] + sR[(2 * 5 + ci) * 64 + c2] + sR[(3 * 5 + ci) * 64 + c2];
        mod[((size_t)l * 5 + ci) * 6144 + ch * 64 + c2] = s + P.in[I_ADAB][l * 6144 + ch * 64 + c2];
      }
      __syncthreads();
    }
  }
  for (int i = 0; i < 2; ++i) {
    transpose_w(P.in[I_EWIN] + (size_t)i * 1024 * 2336, (u16*)(ws + W_EIN) + (size_t)i * EIN_PAD * 1024, 2336, EIN_PAD);
    transpose_w(P.in[I_OWIN] + (size_t)i * 1024 * 3072, (u16*)(ws + W_OIN) + (size_t)i * 3072 * 1024, 3072, 3072);
    transpose_w(P.in[I_EWOUT] + (size_t)i * 1024 * 1024, (u16*)(ws + W_EOUT) + (size_t)i * 1024 * 1024, 1024, 1024);
    transpose_w(P.in[I_OWOUT] + (size_t)i * 1024 * 1024, (u16*)(ws + W_OOUT) + (size_t)i * 1024 * 1024, 1024, 1024);
  }
  for (int l = 0; l < 4; ++l)
    transpose_w(P.in[I_PWQ] + (size_t)l * 1024 * 1024, (u16*)(ws + W_PQ) + (size_t)l * 1024 * 1024, 1024, 1024);
  convert_bf16(P.in[I_PSK], (u16*)(ws + W_SK), 4ull * 8 * 2 * 128 * 64);
  {
    const int lane = tid & 63, wv = tid >> 6;
    for (int row0 = (blockIdx.x * 4 + wv) * 4; row0 < 2 * 65536; row0 += gridDim.x * 16) {
      const int which = row0 >> 16, rr0 = row0 & 65535;
      const float* srcp = P.in[which ? I_PV : I_PU] + (size_t)rr0 * 1024 + lane * 16;
      f32x4 a[4][4];
#pragma unroll
      for (int q = 0; q < 4; ++q)
#pragma unroll
        for (int j = 0; j < 4; ++j) a[q][j] = *(const f32x4*)(srcp + (size_t)q * 1024 + j * 4);
#pragma unroll
      for (int q = 0; q < 4; ++q) {
        float m = 0.f;
#pragma unroll
        for (int j = 0; j < 4; ++j) m = fmaxf(m, fmaxf(fmaxf(fabsf(a[q][j].x), fabsf(a[q][j].y)), fmaxf(fabsf(a[q][j].z), fabsf(a[q][j].w))));
#pragma unroll
        for (int o = 32; o >= 1; o >>= 1) m = fmaxf(m, __shfl_xor(m, o));
        const float sc = (m > 0.f) ? m * (1.f / 440.f) : 1.f;
        const float inv = 1.f / sc;
        if (which) {
          const float sc4 = (m > 0.f) ? m * (1.f / 6.f) : 1.f;
          const float inv4 = 1.f / sc4;
          unsigned w0 = 0, w1 = 0;
          w0 = __builtin_amdgcn_cvt_scalef32_pk_fp4_f32(w0, a[q][0].x * inv4, a[q][0].y * inv4, 1.0f, 0);
          w0 = __builtin_amdgcn_cvt_scalef32_pk_fp4_f32(w0, a[q][0].z * inv4, a[q][0].w * inv4, 1.0f, 1);
          w0 = __builtin_amdgcn_cvt_scalef32_pk_fp4_f32(w0, a[q][1].x * inv4, a[q][1].y * inv4, 1.0f, 2);
          w0 = __builtin_amdgcn_cvt_scalef32_pk_fp4_f32(w0, a[q][1].z * inv4, a[q][1].w * inv4, 1.0f, 3);
          w1 = __builtin_amdgcn_cvt_scalef32_pk_fp4_f32(w1, a[q][2].x * inv4, a[q][2].y * inv4, 1.0f, 0);
          w1 = __builtin_amdgcn_cvt_scalef32_pk_fp4_f32(w1, a[q][2].z * inv4, a[q][2].w * inv4, 1.0f, 1);
          w1 = __builtin_amdgcn_cvt_scalef32_pk_fp4_f32(w1, a[q][3].x * inv4, a[q][3].y * inv4, 1.0f, 2);
          w1 = __builtin_amdgcn_cvt_scalef32_pk_fp4_f32(w1, a[q][3].z * inv4, a[q][3].w * inv4, 1.0f, 3);
          u32x2 o = {w0, w1};
          *(u32x2*)(ws + W_PU + (size_t)(rr0 + q) * 1536 + 1024 + lane * 8) = o;
          if (lane == 0) ((float*)(ws + W_PSV))[rr0 + q] = sc4;
        } else {
          unsigned w[4];
#pragma unroll
          for (int j = 0; j < 4; ++j) {
            int t = __builtin_amdgcn_cvt_pk_fp8_f32(a[q][j].x * inv, a[q][j].y * inv, 0, false);
            t = __builtin_amdgcn_cvt_pk_fp8_f32(a[q][j].z * inv, a[q][j].w * inv, t, true);
            w[j] = (unsigned)t;
          }
          u32x4 o = {w[0], w[1], w[2], w[3]};
          *(u32x4*)(ws + W_PU + (size_t)(rr0 + q) * 1536 + lane * 16) = o;
          if (lane == 0) ((float*)(ws + W_PSU))[rr0 + q] = sc;
        }
      }
    }
  }
  {
    size_t n = 4ull * 2 * 512 * 2 * 64;
    for (size_t idx = gtid; idx < n; idx += gsz) {
      int d = idx & 63, kv = (idx >> 6) & 1, s = (idx >> 7) & 511, i = (idx >> 16) & 1, b = (int)(idx >> 17);
      float kvv = P.in[I_CAK][idx], vv = P.in[I_CAV][idx];
      u16* ka = (u16*)(ws + W_KA_DEC + i * SZ_KA_DEC);
      u16* va = (u16*)(ws + W_VAT_DEC + i * SZ_KA_DEC);
      ka[((size_t)(b * 2 + kv) * 4608 + 4096 + s) * 64 + d] = f2bf(kvv);
      va[((size_t)(b * 2 + kv) * 64 + d) * 4608 + 4096 + s] = f2bf(vv);
    }
    n = 4ull * 2 * 512 * 8 * 2 * 64;
    for (size_t idx = gtid; idx < n; idx += gsz) {
      int d = idx & 63, m = (idx >> 6) & 1, hd = (idx >> 7) & 7, s = (idx >> 10) & 511, i = (idx >> 19) & 1, b = (int)(idx >> 20);
      u16* kc = (u16*)(ws + W_KC_DEC + i * SZ_KC_DEC);
      kc[(((size_t)(b * 8 + hd) * 2 + m) * 4608 + 4096 + s) * 64 + d] = f2bf(P.in[I_CCK][idx]);
    }
    for (size_t idx = gtid; idx < n; idx += gsz) {
      int dv = idx & 127, hd = (idx >> 7) & 7, s = (idx >> 10) & 511, i = (idx >> 19) & 1, b = (int)(idx >> 20);
      u16* vc = (u16*)(ws + W_VCT_DEC + i * SZ_KC_DEC);
      vc[((size_t)(b * 8 + hd) * 128 + dv) * 4608 + 4096 + s] = f2bf(P.in[I_CCV][idx]);
    }
  }
  if (blockIdx.x == 0) {
    float* rt = (float*)(ws + W_ROPE);
    for (int idx = tid; idx < 64 * 16; idx += 256) {
      int p = idx >> 4, f = idx & 15;
      float freq = powf(10000.0f, -(float)f / 16.0f);
      float ang = (float)p * freq;
      rt[idx * 2] = cosf(ang); rt[idx * 2 + 1] = sinf(ang);
    }
    if (tid < 2) {
      float s1 = 0, s2 = 0;
      for (int k = 0; k < 64; ++k) {
        s1 += P.in[I_LQ1][tid * 64 + k] * P.in[I_LK1][tid * 64 + k];
        s2 += P.in[I_LQ2][tid * 64 + k] * P.in[I_LK2][tid * 64 + k];
      }
      ((float*)(ws + W_LAM))[tid] = expf(s1) - expf(s2) + P.lam_init[tid];
      float ga = 0, gk = 0, gc = 0, gck = 0;
      for (int k = 0; k < 64; ++k) {
        ga = fmaxf(ga, fabsf(P.in[I_AQN][tid * 64 + k])); gk = fmaxf(gk, fabsf(P.in[I_AKN][tid * 64 + k]));
        gc = fmaxf(gc, fabsf(P.in[I_CQN][tid * 64 + k])); gck = fmaxf(gck, fabsf(P.in[I_CKN][tid * 64 + k]));
      }
      float ma = 64.f * ga * gk * QSCALE * 1.03f + 0.01f;
      for (int k = 0; k < 8; ++k) ma = fmaxf(ma, P.in[I_ASINK][tid * 8 + k] * LOG2E);
      ((float*)(ws + W_LAM))[2 + tid] = ma;
      ((float*)(ws + W_LAM))[4 + tid] = 64.f * gc * gck * QSCALE * 1.03f + 0.01f;
    }
  }
}

DI void modnorm_row_write(const Params& P, int l, int which, int t, int lane, const float (&xv)[16]) {
  int isdec, b, s, mi; tokinfo(t, isdec, b, s, mi);
  float ss = 0;
#pragma unroll
  for (int j = 0; j < 16; ++j) ss += xv[j] * xv[j];
  ss = wave_sum(ss);
  float rstd = rsqrtf(ss * (1.f / 1024.f) + EPS);
  const float* g = P.in[which ? I_NFG : I_NMG] + l * 1024;
  const float* mod = (const float*)(P.ws + W_MOD) + ((size_t)l * 5 + mi) * 6144;
  const float* sc = mod + (which ? 4 : 1) * 1024;
  const float* sh = mod + (which ? 3 : 0) * 1024;
  u16* h = (u16*)(P.ws + W_H) + (size_t)t * 1024;
#pragma unroll
  for (int j = 0; j < 4; ++j) {
    int c = j * 256 + lane * 4;
    f32x4 gv = *(const f32x4*)(g + c), scv = *(const f32x4*)(sc + c), shv = *(const f32x4*)(sh + c);
    float o0 = xv[j * 4 + 0] * rstd * gv.x * (1.f + scv.x) + shv.x;
    float o1 = xv[j * 4 + 1] * rstd * gv.y * (1.f + scv.y) + shv.y;
    float o2 = xv[j * 4 + 2] * rstd * gv.z * (1.f + scv.z) + shv.z;
    float o3 = xv[j * 4 + 3] * rstd * gv.w * (1.f + scv.w) + shv.w;
    u32x2 o = {pk2(o0, o1), pk2(o2, o3)};
    *(u32x2*)(h + c) = o;
  }
}
DI void modnorm_phase(const Params& P, int l, int which) {
  const int lane = threadIdx.x & 63, wave = threadIdx.x >> 6;
  const bool from_in = (l == 0 && which == 0);
  const int stride = gridDim.x * 4;
  for (int t = blockIdx.x * 4 + wave; t < NTOK; t += 2 * stride) {
    const int t2 = t + stride;
    const bool has2 = t2 < NTOK;
    const int t2c = has2 ? t2 : t;
    const float* xrow = from_in ? ((t < NCTX) ? P.in[I_XP] + (size_t)t * 1024 : P.in[I_XS] + (size_t)(t - NCTX) * 1024) : P.out + O_X + (size_t)t * 1024;
    const float* xrow2 = from_in ? ((t2c < NCTX) ? P.in[I_XP] + (size_t)t2c * 1024 : P.in[I_XS] + (size_t)(t2c - NCTX) * 1024) : P.out + O_X + (size_t)t2c * 1024;
    float xv[16], xw[16];
#pragma unroll
    for (int j = 0; j < 4; ++j) {
      f32x4 v = *(const f32x4*)(xrow + j * 256 + lane * 4);
      f32x4 w = *(const f32x4*)(xrow2 + j * 256 + lane * 4);
      xv[j * 4] = v.x; xv[j * 4 + 1] = v.y; xv[j * 4 + 2] = v.z; xv[j * 4 + 3] = v.w;
      xw[j * 4] = w.x; xw[j * 4 + 1] = w.y; xw[j * 4 + 2] = w.z; xw[j * 4 + 3] = w.w;
    }
    modnorm_row_write(P, l, which, t, lane, xv);
    if (has2) modnorm_row_write(P, l, which, t2, lane, xw);
  }
}

template <class Epi>
DI void gemm_phase(const u16* __restrict__ A, const u16* __restrict__ Wt, int n_tiles, Epi epi, char* smem) {
  constexpr int BK = 64, LDK = 72, NKT = 1024 / BK;
  constexpr int A_ELEMS = 256 * LDK, B_ELEMS = 128 * LDK, STAGE = A_ELEMS + B_ELEMS;
  const int tid = threadIdx.x, lane = tid & 63, wave = tid >> 6;
  const int wm = wave >> 1, wn = wave & 1, r = lane & 31, h = lane >> 5;
  u16* sbase = (u16*)smem;
  float* sC = (float*)smem;
  const int crw = tid >> 3, ckc = (tid & 7) * 8;
  const int xcd = blockIdx.x & 7, nloc = gridDim.x >> 3;
  for (int q = blockIdx.x >> 3; q < 12 * n_tiles; q += nloc) {
    const int mt = xcd * 12 + q / n_tiles, nt = q % n_tiles;
    const u16* Ab = A + (size_t)mt * 256 * 1024 + (size_t)crw * 1024 + ckc;
    const u16* Bb = Wt + (size_t)nt * 128 * 1024 + (size_t)crw * 1024 + ckc;
    f32x16 acc[4][2];
#pragma unroll
    for (int i = 0; i < 4; ++i)
#pragma unroll
      for (int j = 0; j < 2; ++j)
#pragma unroll
        for (int g = 0; g < 16; ++g) acc[i][j][g] = 0.f;
    u32x4 ra[8], rb[4];
#pragma unroll
    for (int j = 0; j < 8; ++j) ra[j] = *(const u32x4*)(Ab + (size_t)j * 32 * 1024);
#pragma unroll
    for (int j = 0; j < 4; ++j) rb[j] = *(const u32x4*)(Bb + (size_t)j * 32 * 1024);
#pragma unroll
    for (int j = 0; j < 8; ++j) *(u32x4*)(sbase + (crw + 32 * j) * LDK + ckc) = ra[j];
#pragma unroll
    for (int j = 0; j < 4; ++j) *(u32x4*)(sbase + A_ELEMS + (crw + 32 * j) * LDK + ckc) = rb[j];
#pragma unroll
    for (int j = 0; j < 8; ++j) ra[j] = *(const u32x4*)(Ab + (size_t)j * 32 * 1024 + BK);
#pragma unroll
    for (int j = 0; j < 4; ++j) rb[j] = *(const u32x4*)(Bb + (size_t)j * 32 * 1024 + BK);
    __syncthreads();
    for (int kt = 0; kt < NKT; ++kt) {
      const u16* sA = sbase + (kt & 1) * STAGE;
      const u16* sB = sA + A_ELEMS;
      u16* sAn = sbase + ((kt & 1) ^ 1) * STAGE;
      u16* sBn = sAn + A_ELEMS;
#pragma unroll
      for (int ks = 0; ks < 4; ++ks) {
        bf16x8 a[4], b[2];
#pragma unroll
        for (int i = 0; i < 4; ++i) a[i] = ld8(sA + (wm * 128 + i * 32 + r) * LDK + ks * 16 + h * 8);
#pragma unroll
        for (int j = 0; j < 2; ++j) b[j] = ld8(sB + (wn * 64 + j * 32 + r) * LDK + ks * 16 + h * 8);
#pragma unroll
        for (int i = 0; i < 4; ++i)
#pragma unroll
          for (int j = 0; j < 2; ++j) acc[i][j] = MFMA(a[i], b[j], acc[i][j]);
        if (ks == 0 && kt + 1 < NKT) {
#pragma unroll
          for (int j = 0; j < 8; ++j) *(u32x4*)(sAn + (crw + 32 * j) * LDK + ckc) = ra[j];
#pragma unroll
          for (int j = 0; j < 4; ++j) *(u32x4*)(sBn + (crw + 32 * j) * LDK + ckc) = rb[j];
          if (kt + 2 < NKT) {
#pragma unroll
            for (int j = 0; j < 8; ++j) ra[j] = *(const u32x4*)(Ab + (size_t)j * 32 * 1024 + (kt + 2) * BK);
#pragma unroll
            for (int j = 0; j < 4; ++j) rb[j] = *(const u32x4*)(Bb + (size_t)j * 32 * 1024 + (kt + 2) * BK);
          }
        }
      }
      __syncthreads();
    }
#pragma unroll
    for (int i = 0; i < 4; ++i)
#pragma unroll
      for (int j = 0; j < 2; ++j)
#pragma unroll
        for (int g = 0; g < 16; ++g)
          sC[(wm * 128 + i * 32 + crow(g, h)) * 129 + wn * 64 + j * 32 + r] = acc[i][j][g];
    __syncthreads();
    epi(mt * 2, nt, sC);
    epi(mt * 2 + 1, nt, sC + 128 * 129);
    __syncthreads();
  }
}

DI void load32(const float* sC, int base, float (&v)[32]) {
#pragma unroll
  for (int j = 0; j < 32; ++j) v[j] = sC[base + j];
}
DI void headnorm_rope32(float (&v)[32], int a, const float* __restrict__ gain, bool rope, int s, const float* __restrict__ rt, float scale) {
  float ss = 0;
#pragma unroll
  for (int d = 0; d < 32; ++d) ss += v[d] * v[d];
  ss += __shfl_xor(ss, 1);
  float rstd = rsqrtf(ss * (1.f / 64.f) + EPS);
#pragma unroll
  for (int d = 0; d < 32; ++d) v[d] = v[d] * rstd * gain[a * 32 + d];
  if (rope) {
    const float* tb = rt + (a == 0 ? (s >> 6) : (s & 63)) * 32;
#pragma unroll
    for (int f = 0; f < 16; ++f) {
      float cs = tb[f * 2], sn = tb[f * 2 + 1];
      float x1 = v[f], x2 = v[16 + f];
      v[f] = x1 * cs - x2 * sn;
      v[16 + f] = x2 * cs + x1 * sn;
    }
  }
#pragma unroll
  for (int d = 0; d < 32; ++d) v[d] *= scale;
}
DI void store32_bf16(u16* dst, const float (&v)[32]) {
#pragma unroll
  for (int j = 0; j < 4; ++j) {
    u32x4 o = {pk2(v[j * 8], v[j * 8 + 1]), pk2(v[j * 8 + 2], v[j * 8 + 3]), pk2(v[j * 8 + 4], v[j * 8 + 5]), pk2(v[j * 8 + 6], v[j * 8 + 7])};
    *(u32x4*)(dst + j * 8) = o;
  }
}
DI void store32_f32(float* dst, const float (&v)[32]) {
#pragma unroll
  for (int j = 0; j < 8; ++j) {
    f32x4 o = {v[j * 4], v[j * 4 + 1], v[j * 4 + 2], v[j * 4 + 3]};
    *(f32x4*)(dst + j * 4) = o;
  }
}

struct EpiEvenIn {
  const Params* P; int i;
  DI void operator()(int mt, int nt, const float* sC) const {
    const Params& p = *P; char* ws = p.ws;
    const int tid = threadIdx.x;
    const int t0 = mt * 128;
    int isdec, b, s0, mi; tokinfo(t0, isdec, b, s0, mi);
    const float* rt = (const float*)(ws + W_ROPE);
    if (nt == 5) {
      const int c = tid & 127, tg = tid >> 7, kv = c >> 6, d = c & 63;
#pragma unroll 1
      for (int q = 0; q < 2; ++q) {
        const int tk = (q * 2 + tg) * 32;
        float v[32];
#pragma unroll
        for (int j = 0; j < 32; ++j) v[j] = sC[(tk + j) * 129 + c];
        const int s = s0 + tk;
        if (isdec) {
          store32_bf16((u16*)(ws + W_VAT_DEC + i * SZ_KA_DEC) + ((size_t)(b * 2 + kv) * 64 + d) * 4608 + s, v);
        } else {
          store32_bf16((u16*)(ws + W_VAT_CTX) + ((size_t)(b * 2 + kv) * 64 + d) * 256 + s, v);
          float* o = p.out + O_CAV + ((((size_t)b * 2 + i) * 256 + s) * 2 + kv) * 64 + d;
#pragma unroll
          for (int j = 0; j < 32; ++j) o[(size_t)j * 128] = v[j];
        }
      }
      return;
    }
    const int row = tid >> 1, a = tid & 1;
    const int t = t0 + row, s = s0 + row;
#pragma unroll 1
    for (int seg = 0; seg < 2; ++seg) {
      if (nt == 18 && seg == 1) break;
      float v[32];
      load32(sC, row * 129 + seg * 64 + a * 32, v);
      if (nt < 4) {
        int head = nt * 2 + seg;
        headnorm_rope32(v, a, p.in[I_AQN] + i * 64, isdec, s, rt, QSCALE);
        store32_bf16((u16*)(ws + W_Q) + (size_t)t * 1024 + head * 64 + a * 32, v);
      } else if (nt == 4) {
        int kv = seg;
        headnorm_rope32(v, a, p.in[I_AKN] + i * 64, isdec, s, rt, 1.f);
        if (isdec) {
          store32_bf16((u16*)(ws + W_KA_DEC + i * SZ_KA_DEC) + ((size_t)(b * 2 + kv) * 4608 + s) * 64 + a * 32, v);
        } else {
          store32_bf16((u16*)(ws + W_KA_CTX) + ((size_t)(b * 2 + kv) * 256 + s) * 64 + a * 32, v);
          store32_f32(p.out + O_CAK + ((((size_t)b * 2 + i) * 256 + s) * 2 + kv) * 64 + a * 32, v);
        }
      } else if (nt < 8) {
#pragma unroll
        for (int j = 0; j < 32; ++j) v[j] *= 0.125f;
        store32_bf16((u16*)(ws + W_BQ) + (size_t)t * 256 + (nt - 6) * 128 + seg * 64 + a * 32, v);
      } else if (nt < 10) {
        store32_bf16((u16*)(ws + W_BK) + (size_t)t * 256 + (nt - 8) * 128 + seg * 64 + a * 32, v);
      } else if (nt < 14) {
        store32_bf16((u16*)(ws + W_BV) + (size_t)t * 512 + (nt - 10) * 128 + seg * 64 + a * 32, v);
      } else if (nt < 18) {
        store32_bf16((u16*)(ws + W_BR) + (size_t)t * 512 + (nt - 14) * 128 + seg * 64 + a * 32, v);
      } else {
        if (a == 0) store32_f32((float*)(ws + W_BG) + (size_t)t * 32, v);
      }
    }
  }
};

struct EpiOddIn {
  const Params* P; int i;
  DI void operator()(int mt, int nt, const float* sC) const {
    const Params& p = *P; char* ws = p.ws;
    const int tid = threadIdx.x;
    const int t0 = mt * 128;
    int isdec, b, s0, mi; tokinfo(t0, isdec, b, s0, mi);
    const float* rt = (const float*)(ws + W_ROPE);
    if (nt >= 16) {
      const int c = tid & 127, tg = tid >> 7, hd = nt - 16;
#pragma unroll 1
      for (int q = 0; q < 2; ++q) {
        const int tk = (q * 2 + tg) * 32;
        float v[32];
#pragma unroll
        for (int j = 0; j < 32; ++j) v[j] = sC[(tk + j) * 129 + c];
        const int s = s0 + tk;
        if (isdec) {
          store32_bf16((u16*)(ws + W_VCT_DEC + i * SZ_KC_DEC) + ((size_t)(b * 8 + hd) * 128 + c) * 4608 + s, v);
        } else {
          store32_bf16((u16*)(ws + W_VCT_CTX) + ((size_t)(b * 8 + hd) * 128 + c) * 256 + s, v);
          float* o = p.out + O_CCV + ((((size_t)b * 2 + i) * 256 + s) * 8 + hd) * 128 + c;
#pragma unroll
          for (int j = 0; j < 32; ++j) o[(size_t)j * 1024] = v[j];
        }
      }
      return;
    }
    const int row = tid >> 1, a = tid & 1;
    const int t = t0 + row, s = s0 + row;
#pragma unroll 1
    for (int seg = 0; seg < 2; ++seg) {
      float v[32];
      load32(sC, row * 129 + seg * 64 + a * 32, v);
      if (nt < 8) {
        headnorm_rope32(v, a, p.in[I_CQN] + i * 64, isdec, s, rt, QSCALE);
        store32_bf16((u16*)(ws + W_Q) + (size_t)t * 1024 + nt * 128 + seg * 64 + a * 32, v);
      } else {
        int hd = nt - 8, m = seg;
        headnorm_rope32(v, a, p.in[I_CKN] + i * 64, isdec, s, rt, 1.f);
        if (isdec) {
          store32_bf16((u16*)(ws + W_KC_DEC + i * SZ_KC_DEC) + (((size_t)(b * 8 + hd) * 2 + m) * 4608 + s) * 64 + a * 32, v);
        } else {
          store32_bf16((u16*)(ws + W_KC_CTX) + (((size_t)(b * 8 + hd) * 2 + m) * 256 + s) * 64 + a * 32, v);
          store32_f32(p.out + O_CCK + (((((size_t)b * 2 + i) * 256 + s) * 8 + hd) * 2 + m) * 64 + a * 32, v);
        }
      }
    }
  }
};

struct EpiOut {
  const Params* P; int l;
  DI void operator()(int mt, int nt, const float* sC) const {
    const Params& p = *P;
    const int tid = threadIdx.x;
    const int t0 = mt * 128;
    int isdec, b, s0, mi; tokinfo(t0, isdec, b, s0, mi);
    const int c = (tid & 31) * 4;
    const float* g1 = (const float*)(p.ws + W_MOD) + ((size_t)l * 5 + mi) * 6144 + 2 * 1024 + nt * 128 + c;
    f32x4 gv = *(const f32x4*)g1;
    float* x = p.out + O_X;
    const float* xin = (l != 0) ? (const float*)x : ((t0 < NCTX) ? p.in[I_XP] : p.in[I_XS] - (size_t)NCTX * 1024);
#pragma unroll
    for (int j = 0; j < 16; ++j) {
      int row = (tid >> 5) + 8 * j;
      f32x4* xp = (f32x4*)(x + (size_t)(t0 + row) * 1024 + nt * 128 + c);
      f32x4 xv = *(const f32x4*)(xin + (size_t)(t0 + row) * 1024 + nt * 128 + c);
      const float* cc = sC + row * 129 + c;
      xv.x += gv.x * cc[0]; xv.y += gv.y * cc[1]; xv.z += gv.z * cc[2]; xv.w += gv.w * cc[3];
      *xp = xv;
    }
  }
};

struct EpiPQ {
  const Params* P;
  DI void operator()(int mt, int nt, const float* sC) const {
    const int tid = threadIdx.x;
    const int c = (tid & 31) * 4;
    u16* q = (u16*)(P->ws + W_Q);
#pragma unroll
    for (int j = 0; j < 16; ++j) {
      int row = (tid >> 5) + 8 * j;
      const float* cc = sC + row * 129 + c;
      u32x2 o = {pk2(cc[0], cc[1]), pk2(cc[2], cc[3])};
      *(u32x2*)(q + (size_t)(mt * 128 + row) * 1024 + nt * 128 + c) = o;
    }
  }
};

template <int DV, bool DIFF, int QG>
DI void attn_item(const u16* __restrict__ Qb  , const u16* __restrict__ Kb, size_t kmap_stride,
                  const u16* __restrict__ VT, int vt_stride, int ta0, int ta1, int tb0, int tb1, bool window, int qpos0,
                  float Mb, float sinkp, float lam, const float* __restrict__ onorm, float oscale,
                  u16* __restrict__ Ob  , char* smem) {
  constexpr int RB = DV / 32;
  constexpr int KMAPS = DIFF ? 2 : 1;
  constexpr int KBUF = KMAPS * 64 * 72, VBUF = DV * 72;
  const int tid = threadIdx.x, lane = tid & 63, wave = tid >> 6, r = lane & 31, h = lane >> 5;
  const int mw = DIFF ? (wave >> 1) : 0;
  const int qrow0 = DIFF ? ((wave & 1) * QG * 32 + r) : (wave * QG * 32 + r);
  u16* sK = (u16*)smem;
  u16* sV = sK + 2 * KBUF;
  const int c0 = tid, c1 = tid + 256, c2 = tid + 512, c3 = tid + 768;
  bf16x8 qf[QG][4];
#pragma unroll
  for (int qg = 0; qg < QG; ++qg)
#pragma unroll
    for (int ks = 0; ks < 4; ++ks) qf[qg][ks] = ld8(Qb + (size_t)(qrow0 + qg * 32) * 1024 + mw * 64 + ks * 16 + h * 8);
  f32x16 acc[QG][RB];
  float lrun[QG];
#pragma unroll
  for (int qg = 0; qg < QG; ++qg) {
#pragma unroll
    for (int rb = 0; rb < RB; ++rb)
#pragma unroll
      for (int g = 0; g < 16; ++g) acc[qg][rb][g] = 0.f;
    lrun[qg] = (h == 0) ? sinkp : 0.f;
  }
  const int na = ta1 - ta0, ntl = na + (tb1 - tb0);
  u32x4 st0, st1, st2, st3;
  {
    const int tile = (0 < na) ? ta0 : tb0;
    const u16* kp = Kb + (size_t)tile * 64 * 64;
    st0 = *(const u32x4*)(kp + (size_t)(c0 >> 3) * 64 + (c0 & 7) * 8);
    st1 = *(const u32x4*)(kp + (size_t)(c1 >> 3) * 64 + (c1 & 7) * 8);
    if (KMAPS > 1) {
      st2 = *(const u32x4*)(kp + kmap_stride + (size_t)(c0 >> 3) * 64 + (c0 & 7) * 8);
      st3 = *(const u32x4*)(kp + kmap_stride + (size_t)(c1 >> 3) * 64 + (c1 & 7) * 8);
    }
    *(u32x4*)(sK + (c0 >> 3) * 72 + (c0 & 7) * 8) = st0;
    *(u32x4*)(sK + (c1 >> 3) * 72 + (c1 & 7) * 8) = st1;
    if (KMAPS > 1) {
      *(u32x4*)(sK + 64 * 72 + (c0 >> 3) * 72 + (c0 & 7) * 8) = st2;
      *(u32x4*)(sK + 64 * 72 + (c1 >> 3) * 72 + (c1 & 7) * 8) = st3;
    }
    const u16* vp = VT + (size_t)tile * 64;
    st0 = *(const u32x4*)(vp + (size_t)(c0 >> 3) * vt_stride + (c0 & 7) * 8);
    st1 = *(const u32x4*)(vp + (size_t)(c1 >> 3) * vt_stride + (c1 & 7) * 8);
    if (DV > 64) {
      st2 = *(const u32x4*)(vp + (size_t)(c2 >> 3) * vt_stride + (c2 & 7) * 8);
      st3 = *(const u32x4*)(vp + (size_t)(c3 >> 3) * vt_stride + (c3 & 7) * 8);
    }
    *(u32x4*)(sV + (c0 >> 3) * 72 + (c0 & 7) * 8) = st0;
    *(u32x4*)(sV + (c1 >> 3) * 72 + (c1 & 7) * 8) = st1;
    if (DV > 64) {
      *(u32x4*)(sV + (c2 >> 3) * 72 + (c2 & 7) * 8) = st2;
      *(u32x4*)(sV + (c3 >> 3) * 72 + (c3 & 7) * 8) = st3;
    }
  }
  for (int it = 0; it < ntl; ++it) {
    const int tile = (it < na) ? (ta0 + it) : (tb0 + it - na);
    const int cur = it & 1, nxt = cur ^ 1;
    const bool more = (it + 1 < ntl);
    const int ntile = (it + 1 < na) ? (ta0 + it + 1) : (tb0 + it + 1 - na);
    const u16* sKc = sK + cur * KBUF + mw * 64 * 72;
    const u16* sVc = sV + cur * VBUF;
    __syncthreads();
    if (more) {
      const u16* kp = Kb + (size_t)ntile * 64 * 64;
      st0 = *(const u32x4*)(kp + (size_t)(c0 >> 3) * 64 + (c0 & 7) * 8);
      st1 = *(const u32x4*)(kp + (size_t)(c1 >> 3) * 64 + (c1 & 7) * 8);
      if (KMAPS > 1) {
        st2 = *(const u32x4*)(kp + kmap_stride + (size_t)(c0 >> 3) * 64 + (c0 & 7) * 8);
        st3 = *(const u32x4*)(kp + kmap_stride + (size_t)(c1 >> 3) * 64 + (c1 & 7) * 8);
      }
    }
    const bool domask = window && (it < na);
    f32x16 s[QG][2];
#pragma unroll
    for (int kb = 0; kb < 2; ++kb) {
#pragma unroll
      for (int qg = 0; qg < QG; ++qg)
#pragma unroll
        for (int g = 0; g < 16; ++g) s[qg][kb][g] = -Mb;
#pragma unroll
      for (int ks = 0; ks < 4; ++ks) {
        bf16x8 a = ld8(sKc + (kb * 32 + pi32(r)) * 72 + ks * 16 + h * 8);
#pragma unroll
        for (int qg = 0; qg < QG; ++qg) s[qg][kb] = MFMA(a, qf[qg][ks], s[qg][kb]);
      }
    }
    bf16x8 pf[QG][2][2];
#pragma unroll
    for (int qg = 0; qg < QG; ++qg) {
      if (domask) {
        const int qpos = qpos0 + qrow0 + qg * 32;
#pragma unroll
        for (int kb = 0; kb < 2; ++kb)
#pragma unroll
          for (int g = 0; g < 16; ++g) {
            int kpos = tile * 64 + kb * 32 + 16 * (g >> 3) + 8 * h + (g & 7);
            int dlt = qpos - kpos;
            if (dlt > 128 || dlt < -128) s[qg][kb][g] = -INFINITY;
          }
      }
      float ls = 0.f;
#pragma unroll
      for (int kb = 0; kb < 2; ++kb)
#pragma unroll
        for (int g = 0; g < 16; ++g) { float pv = __builtin_amdgcn_exp2f(s[qg][kb][g]); s[qg][kb][g] = pv; ls += pv; }
      lrun[qg] += ls;
#pragma unroll
      for (int kb = 0; kb < 2; ++kb)
#pragma unroll
        for (int s2 = 0; s2 < 2; ++s2) {
          u32x4 u = {pk2(s[qg][kb][8 * s2], s[qg][kb][8 * s2 + 1]), pk2(s[qg][kb][8 * s2 + 2], s[qg][kb][8 * s2 + 3]),
                     pk2(s[qg][kb][8 * s2 + 4], s[qg][kb][8 * s2 + 5]), pk2(s[qg][kb][8 * s2 + 6], s[qg][kb][8 * s2 + 7])};
          pf[qg][kb][s2] = __builtin_bit_cast(bf16x8, u);
        }
    }
    if (more) {
      u16* sKn = sK + nxt * KBUF;
      *(u32x4*)(sKn + (c0 >> 3) * 72 + (c0 & 7) * 8) = st0;
      *(u32x4*)(sKn + (c1 >> 3) * 72 + (c1 & 7) * 8) = st1;
      if (KMAPS > 1) {
        *(u32x4*)(sKn + 64 * 72 + (c0 >> 3) * 72 + (c0 & 7) * 8) = st2;
        *(u32x4*)(sKn + 64 * 72 + (c1 >> 3) * 72 + (c1 & 7) * 8) = st3;
      }
      const u16* vp = VT + (size_t)ntile * 64;
      st0 = *(const u32x4*)(vp + (size_t)(c0 >> 3) * vt_stride + (c0 & 7) * 8);
      st1 = *(const u32x4*)(vp + (size_t)(c1 >> 3) * vt_stride + (c1 & 7) * 8);
      if (DV > 64) {
        st2 = *(const u32x4*)(vp + (size_t)(c2 >> 3) * vt_stride + (c2 & 7) * 8);
        st3 = *(const u32x4*)(vp + (size_t)(c3 >> 3) * vt_stride + (c3 & 7) * 8);
      }
    }
#pragma unroll
    for (int rb = 0; rb < RB; ++rb)
#pragma unroll
      for (int kb = 0; kb < 2; ++kb)
#pragma unroll
        for (int s2 = 0; s2 < 2; ++s2) {
          bf16x8 v = ld8(sVc + (rb * 32 + r) * 72 + kb * 32 + s2 * 16 + h * 8);
#pragma unroll
          for (int qg = 0; qg < QG; ++qg) acc[qg][rb] = MFMA(v, pf[qg][kb][s2], acc[qg][rb]);
        }
    if (more) {
      u16* sVn = sV + nxt * VBUF;
      *(u32x4*)(sVn + (c0 >> 3) * 72 + (c0 & 7) * 8) = st0;
      *(u32x4*)(sVn + (c1 >> 3) * 72 + (c1 & 7) * 8) = st1;
      if (DV > 64) {
        *(u32x4*)(sVn + (c2 >> 3) * 72 + (c2 & 7) * 8) = st2;
        *(u32x4*)(sVn + (c3 >> 3) * 72 + (c3 & 7) * 8) = st3;
      }
    }
  }
  float inv[QG];
#pragma unroll
  for (int qg = 0; qg < QG; ++qg) { const float lt = lrun[qg] + __shfl_xor(lrun[qg], 32); inv[qg] = 1.f / lt; }
  if (!DIFF) {
#pragma unroll
    for (int qg = 0; qg < QG; ++qg) {
      u16* orow = Ob + (size_t)(qrow0 + qg * 32) * 1024;
#pragma unroll
      for (int rb = 0; rb < RB; ++rb)
#pragma unroll
        for (int g4 = 0; g4 < 4; ++g4) {
          u32x2 o = {pk2(acc[qg][rb][g4 * 4] * inv[qg], acc[qg][rb][g4 * 4 + 1] * inv[qg]),
                     pk2(acc[qg][rb][g4 * 4 + 2] * inv[qg], acc[qg][rb][g4 * 4 + 3] * inv[qg])};
          *(u32x2*)(orow + rb * 32 + 8 * g4 + 4 * h) = o;
        }
    }
    __syncthreads();
  } else {
    float* sX = (float*)smem;
    __syncthreads();
    if (mw == 1) {
#pragma unroll
      for (int qg = 0; qg < QG; ++qg) {
        const float c1f = lam * inv[qg];
#pragma unroll
        for (int rb = 0; rb < RB; ++rb)
#pragma unroll
          for (int g = 0; g < 16; ++g) sX[((((wave & 1) * QG + qg) * RB + rb) * 16 + g) * 64 + lane] = acc[qg][rb][g] * c1f;
      }
    }
    __syncthreads();
    if (mw == 0) {
#pragma unroll
      for (int qg = 0; qg < QG; ++qg) {
        float ss = 0.f;
#pragma unroll
        for (int rb = 0; rb < RB; ++rb)
#pragma unroll
          for (int g = 0; g < 16; ++g) {
            float o = acc[qg][rb][g] * inv[qg] - sX[((((wave & 1) * QG + qg) * RB + rb) * 16 + g) * 64 + lane];
            acc[qg][rb][g] = o; ss += o * o;
          }
        ss += __shfl_xor(ss, 32);
        const float rstd = rsqrtf(ss * (1.f / DV) + EPS) * oscale;
        u16* orow = Ob + (size_t)(qrow0 + qg * 32) * 1024;
#pragma unroll
        for (int rb = 0; rb < RB; ++rb)
#pragma unroll
          for (int g4 = 0; g4 < 4; ++g4) {
            int dv = rb * 32 + 8 * g4 + 4 * h;
            f32x4 gn = *(const f32x4*)(onorm + dv);
            u32x2 o = {pk2(acc[qg][rb][g4 * 4] * rstd * gn.x, acc[qg][rb][g4 * 4 + 1] * rstd * gn.y),
                       pk2(acc[qg][rb][g4 * 4 + 2] * rstd * gn.z, acc[qg][rb][g4 * 4 + 3] * rstd * gn.w)};
            *(u32x2*)(orow + dv) = o;
          }
      }
    }
    __syncthreads();
  }
}

DI void attnA_item(const Params& P, int i, int item, char* smem) {
  char* ws = P.ws;
  const u16* Q = (const u16*)(ws + W_Q);
  u16* O = (u16*)(ws + W_OMIX);
  int t0, head, ta0, ta1, tb0, tb1, vts, qpos0; bool window;
  const u16* Kb; const u16* VT;
  if (item < 512) {
    int n = item & 15, b = item >> 7; head = (item >> 4) & 7;
    int kv = head >> 2;
    t0 = NCTX + b * 4096 + n * 256;
    Kb = (const u16*)(ws + W_KA_DEC + i * SZ_KA_DEC) + (size_t)(b * 2 + kv) * 4608 * 64;
    VT = (const u16*)(ws + W_VAT_DEC + i * SZ_KA_DEC) + (size_t)(b * 2 + kv) * 64 * 4608;
    ta0 = max(0, 4 * n - 2); ta1 = min(64, 4 * n + 6); tb0 = 64; tb1 = 72; vts = 4608; window = true; qpos0 = n * 256;
  } else {
    int it = item - 512;
    int b = it >> 3; head = it & 7;
    int kv = head >> 2;
    t0 = b * 256;
    Kb = (const u16*)(ws + W_KA_CTX) + (size_t)(b * 2 + kv) * 256 * 64;
    VT = (const u16*)(ws + W_VAT_CTX) + (size_t)(b * 2 + kv) * 64 * 256;
    ta0 = 0; ta1 = 4; tb0 = 0; tb1 = 0; vts = 256; window = false; qpos0 = 0;
  }
  float Mb = ((const float*)(ws + W_LAM))[2 + i];
  float sinkp = __builtin_amdgcn_exp2f(P.in[I_ASINK][i * 8 + head] * LOG2E - Mb);
  attn_item<64, false, 2>(Q + (size_t)t0 * 1024 + head * 64, Kb, 0, VT, vts, ta0, ta1, tb0, tb1, window, qpos0, Mb, sinkp, 0.f, nullptr, 1.f,
                          O + (size_t)t0 * 1024 + head * 64, smem);
}
DI void attnC_phase(const Params& P, int i, char* smem) {
  char* ws = P.ws;
  const u16* Q = (const u16*)(ws + W_Q);
  u16* O = (u16*)(ws + W_OMIX);
  const float lam = ((const float*)(ws + W_LAM))[i];
  const float oscale = 1.f - P.lam_init[i];
  const float* onorm = P.in[I_CON] + i * 128;
  const float Mb = ((const float*)(ws + W_LAM))[4 + i];
  const int xcd = blockIdx.x & 7, local = blockIdx.x >> 3, nloc = gridDim.x >> 3;
  for (int q = local; q < 4 * 32 + 64; q += nloc) {
    int t0, head, nt, tk;
    const u16* Kb; const u16* VT;
    if (q < 128) {
      const int pair = xcd + 8 * (q >> 5), n = q & 31, b = pair >> 3; head = pair & 7;
      t0 = NCTX + b * 4096 + n * 128;
      Kb = (const u16*)(ws + W_KC_DEC + i * SZ_KC_DEC) + (size_t)(b * 8 + head) * 2 * 4608 * 64;
      VT = (const u16*)(ws + W_VCT_DEC + i * SZ_KC_DEC) + (size_t)(b * 8 + head) * 128 * 4608;
      nt = 72; tk = 4608;
    } else {
      const int it = q - 128;
      const int pair = xcd + 8 * (it >> 1), n = it & 1, b = pair >> 3; head = pair & 7;
      t0 = b * 256 + n * 128;
      Kb = (const u16*)(ws + W_KC_CTX) + (size_t)(b * 8 + head) * 2 * 256 * 64;
      VT = (const u16*)(ws + W_VCT_CTX) + (size_t)(b * 8 + head) * 128 * 256;
      nt = 4; tk = 256;
    }
    attn_item<128, true, 2>(Q + (size_t)t0 * 1024 + head * 128, Kb, (size_t)tk * 64, VT, tk, 0, nt, 0, 0, false, 0, Mb, 0.f, lam, onorm, oscale,
                            O + (size_t)t0 * 1024 + head * 128, smem);
  }
}

DI float log_sigmoid_f(float z) { return fminf(z, 0.f) - log1pf(__expf(-fabsf(z))); }

DI void gla_gates(const Params& P, int i, int hd, int dir, const float* sBG, float* sB) {
  const int tid = threadIdx.x, d = tid & 63, jq = tid >> 6;
  const float* gw = P.in[dir ? I_GWB : I_GWF] + (size_t)i * 16 * 256 + hd * 64 + d;
  const float gb = P.in[dir ? I_GBB : I_GBF][i * 256 + hd * 64 + d];
  float w[16];
#pragma unroll
  for (int rr = 0; rr < 16; ++rr) w[rr] = gw[rr * 256];
  for (int j = jq * 16; j < jq * 16 + 16; ++j) {
    float z = gb;
#pragma unroll
    for (int rr = 0; rr < 16; ++rr) z += sBG[j * 33 + dir * 16 + rr] * w[rr];
    sB[j * 65 + d] = log_sigmoid_f(z) * (1.f / 16.f);
  }
  __syncthreads();
  if (tid < 64) {
    float run = 0.f;
    if (dir == 0) { for (int j = 0; j < 64; ++j) { run += sB[j * 65 + tid]; sB[j * 65 + tid] = run; } }
    else { for (int j = 63; j >= 0; --j) { run += sB[j * 65 + tid]; sB[j * 65 + tid] = run; } }
  }
  __syncthreads();
}
DI void gla_load_common(const Params& P, int t0, int hd, float* sBG, u16* sVT) {
  const int tid = threadIdx.x;
  const float* bg = (const float*)(P.ws + W_BG) + (size_t)t0 * 32;
  for (int idx = tid; idx < 2048; idx += 256) sBG[(idx >> 5) * 33 + (idx & 31)] = bg[idx];
  {
    int j = tid & 63, vg = tid >> 6;
    const u16* src = (const u16*)(P.ws + W_BV) + (size_t)(t0 + j) * 512 + hd * 128 + vg * 32;
#pragma unroll
    for (int q = 0; q < 4; ++q) {
      u32x4 u = *(const u32x4*)(src + q * 8);
      unsigned w4[4] = {u.x, u.y, u.z, u.w};
#pragma unroll
      for (int e = 0; e < 4; ++e) {
        sVT[(vg * 32 + q * 8 + e * 2) * 72 + j] = (u16)(w4[e] & 0xffffu);
        sVT[(vg * 32 + q * 8 + e * 2 + 1) * 72 + j] = (u16)(w4[e] >> 16);
      }
    }
  }
}

DI void gla_b1_item(const Params& P, int i, int item, char* smem) {
  const int cgk = item >> 2, hd = item & 3, t0 = cgk * 64;
  const int tid = threadIdx.x, lane = tid & 63, wave = tid >> 6, r = lane & 31, h = lane >> 5;
  u16* sVT = (u16*)smem;
  float* sBG = (float*)(smem + 18432);
  float* sB = (float*)(smem + 18432 + 8448);
  u16* sKT = (u16*)(smem + 18432 + 8448 + 16640);
  gla_load_common(P, t0, hd, sBG, sVT);
  __syncthreads();
  for (int dir = 0; dir < 2; ++dir) {
    gla_gates(P, i, hd, dir, sBG, sB);
    {
      int d = tid & 63, jq = tid >> 6;
      float tot = (dir == 0) ? sB[63 * 65 + d] : sB[d];
      const u16* kp = (const u16*)(P.ws + W_BK) + (size_t)t0 * 256 + hd * 64 + d;
      for (int j = jq * 16; j < jq * 16 + 16; ++j) {
        float kvv = bf2f(kp[(size_t)j * 256]);
        sKT[d * 72 + j] = f2bf(kvv * __expf(tot - sB[j * 65 + d]));
      }
      if (jq == 0) ((float*)(P.ws + W_DEC))[((size_t)item * 2 + dir) * 64 + d] = __expf(tot);
    }
    __syncthreads();
    {
      int dblk = wave >> 1, vh = wave & 1;
      f32x16 acc[2];
#pragma unroll
      for (int jv = 0; jv < 2; ++jv)
#pragma unroll
        for (int g = 0; g < 16; ++g) acc[jv][g] = 0.f;
#pragma unroll
      for (int ks = 0; ks < 4; ++ks) {
        bf16x8 a = ld8(sKT + (dblk * 32 + r) * 72 + ks * 16 + h * 8);
#pragma unroll
        for (int jv = 0; jv < 2; ++jv) {
          bf16x8 bb = ld8(sVT + (vh * 64 + jv * 32 + r) * 72 + ks * 16 + h * 8);
          acc[jv] = MFMA(a, bb, acc[jv]);
        }
      }
      float* kvo = (float*)(P.ws + W_KV) + ((size_t)item * 2 + dir) * 8192;
#pragma unroll
      for (int jv = 0; jv < 2; ++jv)
#pragma unroll
        for (int g = 0; g < 16; ++g) kvo[(dblk * 32 + crow(g, h)) * 128 + vh * 64 + jv * 32 + r] = acc[jv][g];
    }
    __syncthreads();
  }
}

DI void gla_scan_phase(const Params& P, int i) {
  const int tid = threadIdx.x;
  for (int item = blockIdx.x; item < 36 * 4 * 2 * 8; item += gridDim.x) {
    int slab = item & 7, dir = (item >> 3) & 1, hd = (item >> 4) & 3, seq = item >> 6;
    int cg0, NC, b, isdec;
    if (seq < 32) { isdec = 0; b = seq; cg0 = b * 4; NC = 4; } else { isdec = 1; b = seq - 32; cg0 = 128 + b * 64; NC = 64; }
    int e = slab * 1024 + tid * 4, d = e >> 7;
    f32x4 s = {0.f, 0.f, 0.f, 0.f};
    if (isdec) s = *(const f32x4*)(P.in[dir ? I_SBB : I_SBF] + (((size_t)b * 2 + i) * 4 + hd) * 8192 + e);
    float* kvb = (float*)(P.ws + W_KV);
    const float* decb = (const float*)(P.ws + W_DEC);
    for (int n4 = 0; n4 < NC; n4 += 4) {
      f32x4 tmp[4]; float dc[4];
#pragma unroll
      for (int u = 0; u < 4; ++u) {
        int n = dir ? (NC - 1 - (n4 + u)) : (n4 + u);
        size_t ci = ((size_t)(cg0 + n) * 4 + hd) * 2 + dir;
        tmp[u] = *(const f32x4*)(kvb + ci * 8192 + e);
        dc[u] = decb[ci * 64 + d];
      }
#pragma unroll
      for (int u = 0; u < 4; ++u) {
        int n = dir ? (NC - 1 - (n4 + u)) : (n4 + u);
        size_t ci = ((size_t)(cg0 + n) * 4 + hd) * 2 + dir;
        *(f32x4*)(kvb + ci * 8192 + e) = s;
        s.x = dc[u] * s.x + tmp[u].x; s.y = dc[u] * s.y + tmp[u].y; s.z = dc[u] * s.z + tmp[u].z; s.w = dc[u] * s.w + tmp[u].w;
      }
    }
    if (!isdec) *(f32x4*)(P.out + (dir ? O_SBB : O_SBF) + (((size_t)b * 2 + i) * 4 + hd) * 8192 + e) = s;
  }
}

DI void gla_b3_item(const Params& P, int i, int item, char* smem) {
  const int cgk = item >> 2, hd = item & 3, t0 = cgk * 64;
  const int tid = threadIdx.x, lane = tid & 63, wave = tid >> 6, r = lane & 31, h = lane >> 5;
  u16* sVT = (u16*)smem;
  u16* sA = (u16*)(smem + 18432);
  float* sBG = (float*)(smem + 27648);
  float* sB = (float*)(smem + 36096);
  u16* sQD = (u16*)(smem + 52736);
  u16* sKD = (u16*)(smem + 61952);
  float* sO = (float*)(smem + 36096);
  gla_load_common(P, t0, hd, sBG, sVT);
  __syncthreads();
  const int iblk = wave >> 1, jblk = wave & 1;
  f32x16 aacc[2], oacc[2];
#pragma unroll
  for (int u = 0; u < 2; ++u)
#pragma unroll
    for (int g = 0; g < 16; ++g) { aacc[u][g] = 0.f; oacc[u][g] = 0.f; }
#pragma unroll
  for (int dir = 0; dir < 2; ++dir) {
    gla_gates(P, i, hd, dir, sBG, sB);
    {
      int d = tid & 63, jq = tid >> 6;
      const u16* qp = (const u16*)(P.ws + W_BQ) + (size_t)t0 * 256 + hd * 64 + d;
      const u16* kp = (const u16*)(P.ws + W_BK) + (size_t)t0 * 256 + hd * 64 + d;
      for (int j = jq * 16; j < jq * 16 + 16; ++j) {
        float bb = sB[j * 65 + d];
        sQD[j * 72 + d] = f2bf(bf2f(qp[(size_t)j * 256]) * __expf(bb));
        sKD[j * 72 + d] = f2bf(bf2f(kp[(size_t)j * 256]) * __expf(-bb));
      }
    }
    __syncthreads();
#pragma unroll
    for (int ks = 0; ks < 4; ++ks) {
      bf16x8 a = ld8(sQD + (iblk * 32 + r) * 72 + ks * 16 + h * 8);
      bf16x8 bb = ld8(sKD + (jblk * 32 + r) * 72 + ks * 16 + h * 8);
      aacc[dir] = MFMA(a, bb, aacc[dir]);
    }
    const float* S = (const float*)(P.ws + W_KV) + ((size_t)item * 2 + dir) * 8192 + wave * 32 + r;
#pragma unroll
    for (int ks = 0; ks < 4; ++ks) {
      float sv[8];
#pragma unroll
      for (int jj = 0; jj < 8; ++jj) sv[jj] = S[(size_t)(ks * 16 + h * 8 + jj) * 128];
      u32x4 u = {pk2(sv[0], sv[1]), pk2(sv[2], sv[3]), pk2(sv[4], sv[5]), pk2(sv[6], sv[7])};
      bf16x8 bfr = __builtin_bit_cast(bf16x8, u);
#pragma unroll
      for (int it = 0; it < 2; ++it) {
        bf16x8 a = ld8(sQD + (it * 32 + r) * 72 + ks * 16 + h * 8);
        oacc[it] = MFMA(a, bfr, oacc[it]);
      }
    }
    __syncthreads();
  }
#pragma unroll
  for (int g = 0; g < 16; ++g) {
    int ii = iblk * 32 + crow(g, h), jj = jblk * 32 + r;
    float v = (jj <= ii ? aacc[0][g] : 0.f) + (jj >= ii ? aacc[1][g] : 0.f);
    sA[ii * 72 + jj] = f2bf(v);
  }
  __syncthreads();
#pragma unroll
  for (int ks = 0; ks < 4; ++ks) {
    bf16x8 bb = ld8(sVT + (wave * 32 + r) * 72 + ks * 16 + h * 8);
#pragma unroll
    for (int it = 0; it < 2; ++it) {
      bf16x8 a = ld8(sA + (it * 32 + r) * 72 + ks * 16 + h * 8);
      oacc[it] = MFMA(a, bb, oacc[it]);
    }
  }
#pragma unroll
  for (int it = 0; it < 2; ++it)
#pragma unroll
    for (int g = 0; g < 16; ++g) sO[(it * 32 + crow(g, h)) * 129 + wave * 32 + r] = oacc[it][g];
  __syncthreads();
  {
    int ii = tid >> 2, seg = tid & 3;
    float v[32]; float ss = 0.f;
#pragma unroll
    for (int c = 0; c < 32; ++c) { v[c] = sO[ii * 129 + seg * 32 + c]; ss += v[c] * v[c]; }
    ss += __shfl_xor(ss, 1); ss += __shfl_xor(ss, 2);
    float rstd = rsqrtf(ss * (1.f / 128.f) + EPS);
    const float* gn = P.in[I_BON] + i * 128 + seg * 32;
    const u16* br = (const u16*)(P.ws + W_BR) + (size_t)(t0 + ii) * 512 + hd * 128 + seg * 32;
    u16* o = (u16*)(P.ws + W_OMIX) + (size_t)(t0 + ii) * 1024 + 512 + hd * 128 + seg * 32;
#pragma unroll
    for (int q = 0; q < 4; ++q) {
      u32x4 bu = *(const u32x4*)(br + q * 8);
      unsigned bw[4] = {bu.x, bu.y, bu.z, bu.w};
      unsigned ow[4];
#pragma unroll
      for (int e = 0; e < 4; ++e) {
        int c = q * 8 + e * 2;
        float o0 = v[c] * rstd * gn[c] * silu_f(bflo(bw[e]));
        float o1 = v[c + 1] * rstd * gn[c + 1] * silu_f(bfhi(bw[e]));
        ow[e] = pk2(o0, o1);
      }
      u32x4 ou = {ow[0], ow[1], ow[2], ow[3]};
      *(u32x4*)(o + q * 8) = ou;
    }
  }
  __syncthreads();
}

DI unsigned f2key(float f) { unsigned b = __float_as_uint(f); return b ^ ((unsigned)((int)b >> 31) | 0x80000000u); }
DI float key2f(unsigned k) { unsigned b = (k & 0x80000000u) ? (k ^ 0x80000000u) : ~k; return __uint_as_float(b); }
DI void ce_desc(unsigned& x, unsigned& y) { unsigned mx = max(x, y), mn = min(x, y); x = mx; y = mn; }
template <int B, int N>
DI void sort16_desc(unsigned (&a)[N]) {
#pragma unroll
  for (int k = 2; k <= 16; k <<= 1)
#pragma unroll
    for (int j = k >> 1; j > 0; j >>= 1)
#pragma unroll
      for (int i = 0; i < 16; ++i) {
        const int l = i ^ j;
        if (l > i) {
          if ((i & k) == 0) ce_desc(a[B + i], a[B + l]); else ce_desc(a[B + l], a[B + i]);
        }
      }
}
template <int A, int Bo, int N>
DI void merge16_desc(unsigned (&a)[N]) {
#pragma unroll
  for (int i = 0; i < 16; ++i) a[A + i] = max(a[A + i], a[Bo + 15 - i]);
#pragma unroll
  for (int j = 8; j > 0; j >>= 1)
#pragma unroll
    for (int i = 0; i < 16; ++i) {
      const int l = i ^ j;
      if (l > i) ce_desc(a[A + i], a[A + l]);
    }
}
DI void top16_of_64(unsigned (&a)[64]) {
  sort16_desc<0>(a); sort16_desc<16>(a); sort16_desc<32>(a); sort16_desc<48>(a);
  merge16_desc<0, 16>(a); merge16_desc<32, 48>(a); merge16_desc<0, 32>(a);
}

DI void peer_topk_phase(const Params& P, int l, char* smem) {
  const int tid = threadIdx.x, lane = tid & 63, wave = tid >> 6, r = lane & 31, h = lane >> 5;
  const u16* Q = (const u16*)(P.ws + W_Q);
  const u16* SK = (const u16*)(P.ws + W_SK) + (size_t)l * 8 * 2 * 128 * 64;
  for (int wi = blockIdx.x * 4 + wave; wi < (NTOK / 32) * 8; wi += gridDim.x * 4) {
    const int hd = wi & 7, t0 = (wi >> 3) * 32;
    unsigned lst[2][16];
    f32x16 accp[2][4];
    {
      bf16x8 bq[2][4], ak[2][4][4];
#pragma unroll
      for (int p = 0; p < 2; ++p)
#pragma unroll
        for (int ks = 0; ks < 4; ++ks) {
          bq[p][ks] = ld8(Q + (size_t)(t0 + r) * 1024 + hd * 128 + p * 64 + ks * 16 + h * 8);
#pragma unroll
          for (int kt = 0; kt < 4; ++kt) ak[p][ks][kt] = ld8(SK + ((size_t)(hd * 2 + p) * 128 + kt * 32 + r) * 64 + ks * 16 + h * 8);
        }
#pragma unroll
      for (int p = 0; p < 2; ++p) {
#pragma unroll
        for (int kt = 0; kt < 4; ++kt)
#pragma unroll
          for (int g = 0; g < 16; ++g) accp[p][kt][g] = 0.f;
#pragma unroll
        for (int ks = 0; ks < 4; ++ks)
#pragma unroll
          for (int kt = 0; kt < 4; ++kt) accp[p][kt] = MFMA(ak[p][ks][kt], bq[p][ks], accp[p][kt]);
      }
    }
#pragma unroll
    for (int p = 0; p < 2; ++p) {
      f32x16 (&acc)[4] = accp[p];
      unsigned a[64];
#pragma unroll
      for (int kt = 0; kt < 4; ++kt)
#pragma unroll
        for (int g = 0; g < 16; ++g) {
          const int key = kt * 32 + crow(g, h);
          a[kt * 16 + g] = (f2key(acc[kt][g]) & ~127u) | (unsigned)(127 - key);
        }
      top16_of_64(a);
#pragma unroll
      for (int i = 0; i < 16; ++i) a[16 + i] = (unsigned)__shfl_xor((int)a[i], 32);
      merge16_desc<0, 16>(a);
#pragma unroll
      for (int i = 0; i < 16; ++i) lst[p][i] = a[i];
    }
    unsigned c[64];
    {
      float v0[16], v1[16];
#pragma unroll
      for (int k = 0; k < 16; ++k) { v0[k] = key2f(lst[0][k] & ~127u); v1[k] = key2f(lst[1][k] & ~127u); }
      int n = 0;
#pragma unroll
      for (int a = 0; a < 16; ++a)
#pragma unroll
        for (int b = 0; b < 16; ++b)
          if ((a + 1) * (b + 1) <= 16) {
            const unsigned i0 = 127u - (lst[0][a] & 127u), i1 = 127u - (lst[1][b] & 127u);
            c[n] = (f2key(v0[a] + v1[b]) & 0xFFFFC000u) | (i0 << 7) | i1;
            ++n;
          }
#pragma unroll
      for (int k = 50; k < 64; ++k) c[k] = 0u;
    }
    top16_of_64(c);
    float fs[16];
    const float mx = key2f(c[0] & 0xFFFFC000u);
    float sum = 0.f;
#pragma unroll
    for (int k = 0; k < 16; ++k) { fs[k] = __expf(key2f(c[k] & 0xFFFFC000u) - mx); sum += fs[k]; }
    const float inv = 1.f / sum;
    const size_t ob = (size_t)(t0 + r) * 128 + hd * 16;
    if (h == 0) {
      int* eo = (int*)(P.ws + W_EIDX) + ob;
#pragma unroll
      for (int q = 0; q < 4; ++q) {
        u32x4 o = {c[q * 4] & 0x3FFFu, c[q * 4 + 1] & 0x3FFFu, c[q * 4 + 2] & 0x3FFFu, c[q * 4 + 3] & 0x3FFFu};
        *(u32x4*)(eo + q * 4) = o;
      }
    } else {
      float* go = (float*)(P.ws + W_EGATE) + ob;
#pragma unroll
      for (int q = 0; q < 4; ++q) {
        f32x4 o = {fs[q * 4] * inv, fs[q * 4 + 1] * inv, fs[q * 4 + 2] * inv, fs[q * 4 + 3] * inv};
        *(f32x4*)(go + q * 4) = o;
      }
    }
  }
}

DI float dpp_add(float e, float v, int) { return e + v; }
#define DPP_ADD(e, ctrl) ((e) + __int_as_float(__builtin_amdgcn_update_dpp(0, __float_as_int(e), (ctrl), 0xf, 0xf, true)))
DI float reduce4(float d0, float d1, float d2, float d3, int lane) {
  auto r01 = __builtin_amdgcn_permlane32_swap(__float_as_uint(d0), __float_as_uint(d1), false, false);
  const float a = __uint_as_float(r01[0]) + __uint_as_float(r01[1]);
  auto r23 = __builtin_amdgcn_permlane32_swap(__float_as_uint(d2), __float_as_uint(d3), false, false);
  const float c = __uint_as_float(r23[0]) + __uint_as_float(r23[1]);
  auto rq = __builtin_amdgcn_permlane16_swap(__float_as_uint(a), __float_as_uint(c), false, false);
  float e = __uint_as_float(rq[0]) + __uint_as_float(rq[1]);
  e = DPP_ADD(e, 0xB1);
  e = DPP_ADD(e, 0x4E);
  e = DPP_ADD(e, 0x141);
  e = DPP_ADD(e, 0x140);
  return e;
}
DI float dot16_fp8(const u32x4& w, const f32x2_t (&h2)[8]) {
  f32x2_t acc0 = {0.f, 0.f}, acc1 = {0.f, 0.f};
  acc0 = __builtin_amdgcn_cvt_pk_f32_fp8((int)w.x, false) * h2[0] + acc0;
  acc1 = __builtin_amdgcn_cvt_pk_f32_fp8((int)w.x, true) * h2[1] + acc1;
  acc0 = __builtin_amdgcn_cvt_pk_f32_fp8((int)w.y, false) * h2[2] + acc0;
  acc1 = __builtin_amdgcn_cvt_pk_f32_fp8((int)w.y, true) * h2[3] + acc1;
  acc0 = __builtin_amdgcn_cvt_pk_f32_fp8((int)w.z, false) * h2[4] + acc0;
  acc1 = __builtin_amdgcn_cvt_pk_f32_fp8((int)w.z, true) * h2[5] + acc1;
  acc0 = __builtin_amdgcn_cvt_pk_f32_fp8((int)w.w, false) * h2[6] + acc0;
  acc1 = __builtin_amdgcn_cvt_pk_f32_fp8((int)w.w, true) * h2[7] + acc1;
  acc0 += acc1;
  return acc0.x + acc0.y;
}
DI void axpy16_fp8(const u32x4& w, float s, f32x2_t (&y2)[8]) {
  const f32x2_t s2 = {s, s};
  y2[0] = __builtin_amdgcn_cvt_pk_f32_fp8((int)w.x, false) * s2 + y2[0];
  y2[1] = __builtin_amdgcn_cvt_pk_f32_fp8((int)w.x, true) * s2 + y2[1];
  y2[2] = __builtin_amdgcn_cvt_pk_f32_fp8((int)w.y, false) * s2 + y2[2];
  y2[3] = __builtin_amdgcn_cvt_pk_f32_fp8((int)w.y, true) * s2 + y2[3];
  y2[4] = __builtin_amdgcn_cvt_pk_f32_fp8((int)w.z, false) * s2 + y2[4];
  y2[5] = __builtin_amdgcn_cvt_pk_f32_fp8((int)w.z, true) * s2 + y2[5];
  y2[6] = __builtin_amdgcn_cvt_pk_f32_fp8((int)w.w, false) * s2 + y2[6];
  y2[7] = __builtin_amdgcn_cvt_pk_f32_fp8((int)w.w, true) * s2 + y2[7];
}

DI void axpy16_fp4(const u32x2& w, float s, f32x2_t (&y2)[8]) {
  const f32x2_t s2 = {s, s};
  y2[0] = __builtin_amdgcn_cvt_scalef32_pk_f32_fp4(w.x, 1.0f, 0) * s2 + y2[0];
  y2[1] = __builtin_amdgcn_cvt_scalef32_pk_f32_fp4(w.x, 1.0f, 1) * s2 + y2[1];
  y2[2] = __builtin_amdgcn_cvt_scalef32_pk_f32_fp4(w.x, 1.0f, 2) * s2 + y2[2];
  y2[3] = __builtin_amdgcn_cvt_scalef32_pk_f32_fp4(w.x, 1.0f, 3) * s2 + y2[3];
  y2[4] = __builtin_amdgcn_cvt_scalef32_pk_f32_fp4(w.y, 1.0f, 0) * s2 + y2[4];
  y2[5] = __builtin_amdgcn_cvt_scalef32_pk_f32_fp4(w.y, 1.0f, 1) * s2 + y2[5];
  y2[6] = __builtin_amdgcn_cvt_scalef32_pk_f32_fp4(w.y, 1.0f, 2) * s2 + y2[6];
  y2[7] = __builtin_amdgcn_cvt_scalef32_pk_f32_fp4(w.y, 1.0f, 3) * s2 + y2[7];
}
DI void peer_expert_phase(const Params& P, int l) {
  const int lane = threadIdx.x & 63, wave = threadIdx.x >> 6;
  const char* U = P.ws + W_PU + (size_t)l * 16384 * 1536 + lane * 16;
  const char* V = P.ws + W_PU + (size_t)l * 16384 * 1536 + 1024 + lane * 8;
  const float* SU = (const float*)(P.ws + W_PSU) + l * 16384;
  const float* SV = (const float*)(P.ws + W_PSV) + l * 16384;
  float* x = P.out + O_X;
  const int grp = lane >> 4;
  const int tstride = gridDim.x * 4;
  int ni0, ni1; float ng0, ng1; u32x4 nhA, nhB;
  {
    const int tl = min(blockIdx.x * 4 + wave, NTOK - 1);
    const u16* hrow = (const u16*)(P.ws + W_H) + (size_t)tl * 1024 + lane * 16;
    nhA = *(const u32x4*)hrow; nhB = *(const u32x4*)(hrow + 8);
    const int* ei = (const int*)(P.ws + W_EIDX) + (size_t)tl * 128;
    const float* eg = (const float*)(P.ws + W_EGATE) + (size_t)tl * 128;
    ni0 = ei[lane]; ni1 = ei[64 + lane]; ng0 = eg[lane]; ng1 = eg[64 + lane];
  }
  u32x4 un[16]; u32x2 vn[16];
#pragma unroll
  for (int u = 0; u < 16; ++u) {
    const int id = __builtin_amdgcn_readlane(ni0, u);
    un[u] = *(const u32x4*)(U + (size_t)id * 1536);
    vn[u] = *(const u32x2*)(V + (size_t)id * 1536);
  }
  float nsu0 = SU[ni0], nsu1 = SU[ni1], nsv0 = SV[ni0], nsv1 = SV[ni1];
  for (int t = blockIdx.x * 4 + wave; t < NTOK; t += tstride) {
    int isdec, b, s, mi; tokinfo(t, isdec, b, s, mi);
    const u32x4 hA = nhA, hB = nhB;
    const int myi0 = ni0, myi1 = ni1;
    const float graw0 = ng0, graw1 = ng1;
    {
      const int tn = min(t + tstride, NTOK - 1);
      const u16* hrow = (const u16*)(P.ws + W_H) + (size_t)tn * 1024 + lane * 16;
      nhA = *(const u32x4*)hrow; nhB = *(const u32x4*)(hrow + 8);
      const int* ei = (const int*)(P.ws + W_EIDX) + (size_t)tn * 128;
      const float* eg = (const float*)(P.ws + W_EGATE) + (size_t)tn * 128;
      ni0 = ei[lane]; ni1 = ei[64 + lane]; ng0 = eg[lane]; ng1 = eg[64 + lane];
    }
    f32x2_t h2[8] = {{bflo(hA.x), bfhi(hA.x)}, {bflo(hA.y), bfhi(hA.y)}, {bflo(hA.z), bfhi(hA.z)}, {bflo(hA.w), bfhi(hA.w)},
                     {bflo(hB.x), bfhi(hB.x)}, {bflo(hB.y), bfhi(hB.y)}, {bflo(hB.z), bfhi(hB.z)}, {bflo(hB.w), bfhi(hB.w)}};
    float* xr = x + (size_t)t * 1024 + lane * 16;
    const float* g2 = (const float*)(P.ws + W_MOD) + ((size_t)l * 5 + mi) * 6144 + 5 * 1024 + lane * 16;
    f32x4 xpre[4], gpre[4];
#pragma unroll
    for (int q = 0; q < 4; ++q) { xpre[q] = *(const f32x4*)(xr + q * 4); gpre[q] = *(const f32x4*)(g2 + q * 4); }
    const float mysu0 = nsu0, mysu1 = nsu1;
    const float myg0 = graw0 * nsv0, myg1 = graw1 * nsv1;
    f32x2_t y2[8];
#pragma unroll
    for (int j = 0; j < 8; ++j) { y2[j].x = 0.f; y2[j].y = 0.f; }
    for (int e0 = 0; e0 < 128; e0 += 16) {
      u32x4 uc[16]; u32x2 vc[16];
#pragma unroll
      for (int u = 0; u < 16; ++u) { uc[u] = un[u]; vc[u] = vn[u]; }
      {
        const int e1 = (e0 + 16) & 127;
        const int srci = (e0 + 16 < 128) ? ((e1 < 64) ? myi0 : myi1) : ni0;
#pragma unroll
        for (int u = 0; u < 16; ++u) {
          const int id = __builtin_amdgcn_readlane(srci, (e1 + u) & 63);
          un[u] = *(const u32x4*)(U + (size_t)id * 1536);
          vn[u] = *(const u32x2*)(V + (size_t)id * 1536);
        }
      }
      if (e0 == 64) { nsu0 = SU[ni0]; nsu1 = SU[ni1]; nsv0 = SV[ni0]; nsv1 = SV[ni1]; }
      const float gsrc = (e0 < 64) ? myg0 : myg1;
      const float ssrc = (e0 < 64) ? mysu0 : mysu1;
#pragma unroll
      for (int hb = 0; hb < 4; ++hb) {
        float su[4], gt[4];
#pragma unroll
        for (int u = 0; u < 4; ++u) {
          su[u] = __int_as_float(__builtin_amdgcn_readlane(__float_as_int(ssrc), (e0 + hb * 4 + u) & 63));
          gt[u] = __int_as_float(__builtin_amdgcn_readlane(__float_as_int(gsrc), (e0 + hb * 4 + u) & 63));
        }
        float d0 = dot16_fp8(uc[hb * 4 + 0], h2), d1 = dot16_fp8(uc[hb * 4 + 1], h2), d2 = dot16_fp8(uc[hb * 4 + 2], h2), d3 = dot16_fp8(uc[hb * 4 + 3], h2);
        float e = reduce4(d0, d1, d2, d3, lane);
        const float su_s = (grp == 0) ? su[0] : (grp == 1) ? su[2] : (grp == 2) ? su[1] : su[3];
        const float w_s = (grp == 0) ? gt[0] : (grp == 1) ? gt[2] : (grp == 2) ? gt[1] : gt[3];
        const float pre = e * su_s;
        const float act = 0.5f * pre * (1.f + erff(pre * 0.70710678118654752f));
        const float w = act * w_s;
        const float w0 = __int_as_float(__builtin_amdgcn_readlane(__float_as_int(w), 0));
        const float w1 = __int_as_float(__builtin_amdgcn_readlane(__float_as_int(w), 32));
        const float w2 = __int_as_float(__builtin_amdgcn_readlane(__float_as_int(w), 16));
        const float w3 = __int_as_float(__builtin_amdgcn_readlane(__float_as_int(w), 48));
        axpy16_fp4(vc[hb * 4 + 0], w0, y2); axpy16_fp4(vc[hb * 4 + 1], w1, y2); axpy16_fp4(vc[hb * 4 + 2], w2, y2); axpy16_fp4(vc[hb * 4 + 3], w3, y2);
      }
    }
    float xn[16];
#pragma unroll
    for (int q = 0; q < 4; ++q) {
      f32x4 xv = xpre[q], gv = gpre[q];
      xv.x += gv.x * y2[q * 2].x; xv.y += gv.y * y2[q * 2].y; xv.z += gv.z * y2[q * 2 + 1].x; xv.w += gv.w * y2[q * 2 + 1].y;
      *(f32x4*)(xr + q * 4) = xv;
      xn[q * 4] = xv.x; xn[q * 4 + 1] = xv.y; xn[q * 4 + 2] = xv.z; xn[q * 4 + 3] = xv.w;
    }
    if (l < 3) {
      float ss = 0.f;
#pragma unroll
      for (int j = 0; j < 16; ++j) ss += xn[j] * xn[j];
      ss = wave_sum(ss);
      float rstd = rsqrtf(ss * (1.f / 1024.f) + EPS);
      const float* g = P.in[I_NMG] + (l + 1) * 1024 + lane * 16;
      const float* mod = (const float*)(P.ws + W_MOD) + ((size_t)(l + 1) * 5 + mi) * 6144 + lane * 16;
      u16* hh = (u16*)(P.ws + W_H) + (size_t)t * 1024 + lane * 16;
#pragma unroll
      for (int hf = 0; hf < 2; ++hf) {
        float o[8];
#pragma unroll
        for (int q = 0; q < 8; ++q) o[q] = xn[hf * 8 + q] * rstd * g[hf * 8 + q] * (1.f + mod[1024 + hf * 8 + q]) + mod[hf * 8 + q];
        u32x4 ou = {pk2(o[0], o[1]), pk2(o[2], o[3]), pk2(o[4], o[5]), pk2(o[6], o[7])};
        *(u32x4*)(hh + hf * 8) = ou;
      }
    }
  }
}

DI void mixer1_phase(const Params& P, int i, char* smem) {
  const int xcd = blockIdx.x & 7, nloc = gridDim.x >> 3;
  for (int q = blockIdx.x >> 3; q < 96; q += nloc) {
    int item;
    if (q < 64) { const int b = xcd >> 1, head = (xcd & 1) * 4 + (q >> 4), n = q & 15; item = b * 128 + head * 16 + n; }
    else { const int it = q - 64, b = xcd + 8 * (it >> 3), head = it & 7; item = 512 + b * 8 + head; }
    attnA_item(P, i, item, smem);
  }
  for (int item = blockIdx.x; item < 1536; item += gridDim.x) gla_b1_item(P, i, item, smem);
}

#define XB_TMO      128
#define XB_XCNT(j)  (256  + 64 * (j))
#define XB_XSUB(j)  (1280 + 64 * (j))
#define XB_XGEN(j)  (2304 + 64 * (j))
#define XB_TOP      3328
#define XB_TOPGEN   3392
#define XCD_BAR_WORDS 3456
#define XB_SPIN_CAP (1u << 20)
#define LAS __attribute__((address_space(3)))
DI unsigned xb_ld(unsigned* p)              { return __hip_atomic_load(p, __ATOMIC_RELAXED, __HIP_MEMORY_SCOPE_AGENT); }
DI unsigned xb_add(unsigned* p, unsigned v) { return __hip_atomic_fetch_add(p, v, __ATOMIC_RELAXED, __HIP_MEMORY_SCOPE_AGENT); }
DI unsigned xb_xcc_id() { return (unsigned)__builtin_amdgcn_s_getreg((3 << 11) | 20) & 0xFu; }
#define XB_SPIN(cond, bar) do { unsigned _sp = 0; while (cond) { __builtin_amdgcn_s_sleep(1); \
    if ((++_sp & 255u) == 0u) { if (xb_ld(&(bar)[XB_TMO])) break; if (_sp > XB_SPIN_CAP) { atomicAdd(&(bar)[XB_TMO], 1u); break; } } } } while (0)
struct XcdBarrier { unsigned* bar; unsigned x; volatile LAS unsigned* st; };
DI XcdBarrier xcd_barrier_post(unsigned* bar, volatile LAS unsigned* st) {
  XcdBarrier b; b.bar = bar; b.x = xb_xcc_id(); b.st = st;
  if (threadIdx.x == 0) (void)xb_add(&bar[XB_XCNT(b.x)], 1u);
  return b;
}
DI XcdBarrier make_xb(const Params& P, char* smem) {
  XcdBarrier b; b.bar = (unsigned*)(P.ws + W_BAR); b.x = xb_xcc_id(); b.st = (volatile LAS unsigned*)(smem + SMEM_BYTES - 16);
  return b;
}
DI void xcd_barrier_complete(unsigned* bar, unsigned x, unsigned& nloc, unsigned& nx) {
  const unsigned G = gridDim.x * gridDim.y * gridDim.z;
  unsigned sum, cnt, mine, sp = 0u;
  for (;;) {
    sum = 0u; cnt = 0u; mine = 0u;
#pragma unroll
    for (unsigned j = 0; j < 16; ++j) { const unsigned c = xb_ld(&bar[XB_XCNT(j)]); sum += c; cnt += (c > 0u) ? 1u : 0u; mine = (j == x) ? c : mine; }
    if (sum == G) break;
    __builtin_amdgcn_s_sleep(1);
    if ((++sp & 255u) == 0u) { if (xb_ld(&bar[XB_TMO])) break; if (sp > XB_SPIN_CAP) { atomicAdd(&bar[XB_TMO], 1u); break; } }
  }
  nloc = mine > 0u ? mine : 1u; nx = cnt > 0u ? cnt : 1u;
}
DI void xcd_barrier(const XcdBarrier& b) {
  asm volatile("s_waitcnt vmcnt(0)" ::: "memory");
  __syncthreads();
  if (threadIdx.x == 0) {
    unsigned* bar = b.bar;
    __builtin_amdgcn_s_waitcnt(0);
    unsigned nloc = b.st[0], nx = b.st[1];
    if (nloc == 0u) { xcd_barrier_complete(bar, b.x, nloc, nx); b.st[0] = nloc; b.st[1] = nx; }
    const unsigned old = xb_add(&bar[XB_XSUB(b.x)], 1u);
    const unsigned gen = old / nloc;
    if (old + 1u == (gen + 1u) * nloc) {
      __builtin_amdgcn_fence(__ATOMIC_RELEASE, "agent");
      asm volatile("s_waitcnt vmcnt(0)" ::: "memory");
      const unsigned og = xb_add(&bar[XB_TOP], 1u);
      const unsigned tg = og / nx;
      if (og + 1u == (tg + 1u) * nx) xb_add(&bar[XB_TOPGEN], 1u);
      else XB_SPIN(xb_ld(&bar[XB_TOPGEN]) == tg, bar);
      __builtin_amdgcn_fence(__ATOMIC_ACQUIRE, "agent");
      xb_add(&bar[XB_XGEN(b.x)], 1u);
      asm volatile("s_waitcnt vmcnt(0)" ::: "memory");
    } else {
      XB_SPIN(xb_ld(&bar[XB_XGEN(b.x)]) == gen, bar);
      __builtin_amdgcn_fence(__ATOMIC_ACQUIRE, "agent");
      asm volatile("s_waitcnt vmcnt(0)" ::: "memory");
    }
  }
  __syncthreads();
}

#ifndef REP0
#define REP0 1
#define REP1 1
#define REP2 1
#define REP3 1
#define REP4 1
#define REP5 1
#define REP6 1
#endif
#define PHASE(body) { body; xcd_barrier(make_xb(P, smem)); }
#define PHASE_R(c, body) for (int r_ = 0; r_ < P.rep[c]; ++r_) { body; xcd_barrier(make_xb(P, smem)); }
template <int L>
DI void run_layer(const Params& P, char* smem) {
  constexpr int l = L, i = L >> 1;
  if ((l & 1) == 0) {
    PHASE_R(2, gemm_phase((const u16*)(P.ws + W_H), (const u16*)(P.ws + W_EIN) + (size_t)i * EIN_PAD * 1024, 19, EpiEvenIn{&P, i}, smem));
    PHASE_R(3, mixer1_phase(P, i, smem));
    PHASE(gla_scan_phase(P, i));
    PHASE_R(3, { for (int item = blockIdx.x; item < 1536; item += gridDim.x) gla_b3_item(P, i, item, smem); });
    PHASE(gemm_phase((const u16*)(P.ws + W_OMIX), (const u16*)(P.ws + W_EOUT) + (size_t)i * 1024 * 1024, 8, EpiOut{&P, l}, smem));
  } else {
    PHASE_R(2, gemm_phase((const u16*)(P.ws + W_H), (const u16*)(P.ws + W_OIN) + (size_t)i * 3072 * 1024, 24, EpiOddIn{&P, i}, smem));
    PHASE_R(4, attnC_phase(P, i, smem));
    PHASE(gemm_phase((const u16*)(P.ws + W_OMIX), (const u16*)(P.ws + W_OOUT) + (size_t)i * 1024 * 1024, 8, EpiOut{&P, l}, smem));
  }
  PHASE_R(1, modnorm_phase(P, l, 1));
  PHASE_R(5, gemm_phase((const u16*)(P.ws + W_H), (const u16*)(P.ws + W_PQ) + (size_t)l * 1024 * 1024, 8, EpiPQ{&P}, smem));
  PHASE_R(6, peer_topk_phase(P, l, smem));
  if (l < 3) { PHASE(peer_expert_phase(P, l)); } else { peer_expert_phase(P, l); }
}

__global__ void __launch_bounds__(256) trunk_megakernel(Params P) {
  cg::grid_group grid = cg::this_grid();
  __shared__ __attribute__((aligned(16))) char smem[SMEM_BYTES];
  if (threadIdx.x == 0) { u32x4 z = {0u, 0u, 0u, 0u}; *(u32x4*)(smem + SMEM_BYTES - 16) = z; }
  __syncthreads();
  (void)xcd_barrier_post((unsigned*)(P.ws + W_BAR), (volatile LAS unsigned*)(smem + SMEM_BYTES - 16));
  prep_phase(P, smem);
  xcd_barrier(make_xb(P, smem));
  if (P.rep[7] == 0x7fffffff) grid.sync();
  PHASE_R(1, modnorm_phase(P, 0, 0));
  run_layer<0>(P, smem);
  run_layer<1>(P, smem);
  run_layer<2>(P, smem);
  run_layer<3>(P, smem);
}
#undef PHASE
#undef PHASE_R

extern "C" void kernel_launch(void* const* d_in, const int* in_sizes, int n_in, void* d_out, int out_size, void* d_ws, size_t ws_size,
                              hipStream_t stream) {
  static int grid_blocks = 0;
  if (!grid_blocks) {
    int dev = 0, cus = 0, per_cu = 0;
    hipGetDevice(&dev);
    hipDeviceGetAttribute(&cus, hipDeviceAttributeMultiprocessorCount, dev);
    hipOccupancyMaxActiveBlocksPerMultiprocessor(&per_cu, trunk_megakernel, 256, 0);
    if (per_cu > 2) per_cu = 2;
    if (per_cu < 1) per_cu = 1;
    grid_blocks = (cus * per_cu) & ~7;
    if (grid_blocks < 8) grid_blocks = 8;
  }
  Params p{};
  for (int k = 0; k < N_IN; ++k) p.in[k] = (const float*)d_in[k];
  p.out = (float*)d_out;
  p.ws = (char*)d_ws;
  p.lam_init[0] = (float)(0.8 - 0.6 * std::exp(-0.3 * 1.0));
  p.lam_init[1] = (float)(0.8 - 0.6 * std::exp(-0.3 * 3.0));
  p.rep[0] = REP0; p.rep[1] = REP1; p.rep[2] = REP2; p.rep[3] = REP3; p.rep[4] = REP4; p.rep[5] = REP5; p.rep[6] = REP6; p.rep[7] = 1;
  hipMemsetAsync((char*)d_ws + W_BAR, 0, XCD_BAR_WORDS * sizeof(unsigned), stream);
  void* args[] = {&p};
  hipError_t e = hipLaunchCooperativeKernel((void*)trunk_megakernel, dim3(grid_blocks), dim3(256), args, 0, stream);
  if (e != hipSuccess) fprintf(stderr, "cooperative launch failed: %s (grid %d)\n", hipGetErrorString(e), grid_blocks);
}
```
